# Optimizing an MI355X kernel written in HIP

```python
import math
import jax, jax.numpy as jnp
from jax import lax
import numpy as np

D_MODEL = 1024
BATCH = 8
SEQ = 4096
DEPTH = 1

D_MIX = D_MODEL
HEAD_DIM = 64
ATTN_HEADS = 8
ATTN_WIDTH = ATTN_HEADS * HEAD_DIM
DILATED_PATTERNS = ((128, 1), (512, 4), (2048, 16))
ROPE_THETA = 10000.0
SSD_HEADS = 8
SSD_HEAD_DIM = 64
SSD_WIDTH = SSD_HEADS * SSD_HEAD_DIM
SSD_GROUPS = 2
SSD_STATE = 128
SSD_CONV = 5
SSD_CHUNK = 128
SSD_CONV_CH = SSD_WIDTH + 2 * SSD_GROUPS * SSD_STATE
IN_PROJ_COLS = 3 * ATTN_WIDTH + SSD_WIDTH + SSD_CONV_CH + 2 * SSD_HEADS
N_EXPERTS = 32
TOP_K = 4
D_EXPERT = D_MODEL
SWIGLU_ALPHA = 1.702
SWIGLU_LIMIT = 7.0
DEEPNORM_ALPHA = (2.0 * DEPTH) ** 0.25
DEEPNORM_BETA = (8.0 * DEPTH) ** -0.25
NORM_EPS = 1e-5

kernel_name = "hymba_longnet_ssd_moe_deepnorm_encoder"


def layer_norm(x, w, b):
    xf = x.astype(jnp.float32)
    mu = jnp.mean(xf, axis=-1, keepdims=True)
    var = jnp.mean(jnp.square(xf - mu), axis=-1, keepdims=True)
    return (xf - mu) * lax.rsqrt(var + NORM_EPS) * w.astype(jnp.float32) + b.astype(jnp.float32)


def rms_norm(x, w):
    xf = x.astype(jnp.float32)
    return xf * lax.rsqrt(jnp.mean(jnp.square(xf), axis=-1, keepdims=True) + NORM_EPS) * w.astype(jnp.float32)


def rope_tables(s):
    pos = jnp.arange(s, dtype=jnp.float32)
    inv_freq = ROPE_THETA ** (-jnp.arange(0, HEAD_DIM, 2, dtype=jnp.float32) / HEAD_DIM)
    ang = pos[:, None] * inv_freq[None, :]
    return jnp.cos(ang), jnp.sin(ang)


def apply_rope(t, cos, sin):
    t1, t2 = jnp.split(t, 2, axis=-1)
    c = cos[None, :, None, :]
    s = sin[None, :, None, :]
    return jnp.concatenate([t1 * c - t2 * s, t2 * c + t1 * s], axis=-1)


def banded_window_attention(q, k, v, half):
    b, g, L, h, dh = q.shape
    blk = half
    nb = -(-L // blk)
    lp = nb * blk
    q = jnp.pad(q, ((0, 0), (0, 0), (0, lp - L), (0, 0), (0, 0)))
    kv_pad = ((0, 0), (0, 0), (blk, lp - L + blk), (0, 0), (0, 0))
    kb = jnp.pad(k, kv_pad).reshape(b, g, nb + 2, blk, h, dh)
    vb = jnp.pad(v, kv_pad).reshape(b, g, nb + 2, blk, h, dh)
    k_win = jnp.concatenate([kb[:, :, 0:nb], kb[:, :, 1:nb + 1], kb[:, :, 2:nb + 2]], axis=3)
    v_win = jnp.concatenate([vb[:, :, 0:nb], vb[:, :, 1:nb + 1], vb[:, :, 2:nb + 2]], axis=3)
    qb = q.reshape(b, g, nb, blk, h, dh)
    scores = jnp.einsum("bgnqhd,bgnkhd->bgnhqk", qb, k_win) * (dh ** -0.5)
    blocks = jnp.arange(nb)[:, None, None]
    qpos = blocks * blk + jnp.arange(blk)[None, :, None]
    kpos = (blocks - 1) * blk + jnp.arange(3 * blk)[None, None, :]
    valid = (jnp.abs(qpos - kpos) <= half) & (kpos >= 0) & (kpos < L)
    scores = jnp.where(valid[None, None, :, None], scores, -jnp.inf)
    mx = jnp.max(scores, axis=-1)
    p = jnp.exp(scores - mx[..., None])
    den = jnp.sum(p, axis=-1)
    num = jnp.einsum("bgnhqk,bgnkhd->bgnqhd", p, v_win).reshape(b, g, lp, h, dh)[:, :, :L]
    den = den.transpose(0, 1, 2, 4, 3).reshape(b, g, lp, h)[:, :, :L]
    mx = mx.transpose(0, 1, 2, 4, 3).reshape(b, g, lp, h)[:, :, :L]
    return num, den, mx


def dilated_attention(q, k, v):
    b, s, h, dh = q.shape
    nums, dens, mxs = [], [], []
    for window, dil in DILATED_PATTERNS:
        half = window // (2 * dil)
        L = s // dil
        qr = q.reshape(b, L, dil, h, dh).transpose(0, 2, 1, 3, 4)
        kr = k.reshape(b, L, dil, h, dh).transpose(0, 2, 1, 3, 4)
        vr = v.reshape(b, L, dil, h, dh).transpose(0, 2, 1, 3, 4)
        num, den, mx = banded_window_attention(qr, kr, vr, half)
        nums.append(num.transpose(0, 2, 1, 3, 4).reshape(b, s, h, dh))
        dens.append(den.transpose(0, 2, 1, 3).reshape(b, s, h))
        mxs.append(mx.transpose(0, 2, 1, 3).reshape(b, s, h))
    num_all = jnp.stack(nums)
    den_all = jnp.stack(dens)
    mx_all = jnp.stack(mxs)
    w = jnp.exp(mx_all - jnp.max(mx_all, axis=0, keepdims=True))
    return jnp.sum(w[..., None] * num_all, axis=0) / jnp.sum(w * den_all, axis=0)[..., None]


def ssd_chunked(xs, a, bm, cm):
    b, l, h, p = xs.shape
    n = bm.shape[-1]
    t = SSD_CHUNK
    c = l // t
    xs = xs.reshape(b, c, t, h, p)
    bm = bm.reshape(b, c, t, h, n)
    cm = cm.reshape(b, c, t, h, n)
    a = a.reshape(b, c, t, h).transpose(0, 3, 1, 2)
    a_cs = jnp.cumsum(a, axis=-1)
    seg = a_cs[..., :, None] - a_cs[..., None, :]
    tril = jnp.tril(jnp.ones((t, t), dtype=bool))
    lmat = jnp.exp(jnp.where(tril, seg, -jnp.inf))
    cb = jnp.einsum("bclhn,bcshn->bhcls", cm, bm)
    y_diag = jnp.einsum("bhcls,bcshp->bclhp", cb * lmat, xs)
    decay_states = jnp.exp(a_cs[..., -1:] - a_cs)
    states = jnp.einsum("bclhn,bhcl,bclhp->bchpn", bm, decay_states, xs)
    chunk_decay = jnp.exp(a_cs[..., -1])

    def step(state, inp):
        st, dec = inp
        return state * dec[..., None, None] + st, state

    init = jnp.zeros((b, h, p, n), dtype=jnp.float32)
    _, prev = lax.scan(step, init, (states.transpose(1, 0, 2, 3, 4), chunk_decay.transpose(2, 0, 1)))
    prev = prev.transpose(1, 0, 2, 3, 4)
    y_off = jnp.einsum("bclhn,bchpn,bhcl->bclhp", cm, prev, jnp.exp(a_cs))
    return (y_diag + y_off).reshape(b, l, h, p)


def bidirectional_ssd(z, xbc, dt_raw, conv_w, conv_b, dt_bias_fwd, a_log_fwd,
                      dt_bias_bwd, a_log_bwd, d_skip, norm_w):
    b, s, _ = z.shape
    xbc = lax.conv_general_dilated(
        xbc.astype(jnp.float32), conv_w.astype(jnp.float32)[:, None, :], (1,),
        [(SSD_CONV // 2, SSD_CONV // 2)], dimension_numbers=("NWC", "WIO", "NWC"),
        feature_group_count=SSD_CONV_CH) + conv_b.astype(jnp.float32)
    xbc = jax.nn.silu(xbc)
    gn = SSD_GROUPS * SSD_STATE
    xs = xbc[..., :SSD_WIDTH].reshape(b, s, SSD_HEADS, SSD_HEAD_DIM)
    bm = xbc[..., SSD_WIDTH:SSD_WIDTH + gn].reshape(b, s, SSD_GROUPS, SSD_STATE)
    cm = xbc[..., SSD_WIDTH + gn:].reshape(b, s, SSD_GROUPS, SSD_STATE)
    heads_per_group = SSD_HEADS // SSD_GROUPS
    bm = jnp.repeat(bm, heads_per_group, axis=2)
    cm = jnp.repeat(cm, heads_per_group, axis=2)
    dt_raw = dt_raw.astype(jnp.float32)
    dt_f = jax.nn.softplus(dt_raw[..., :SSD_HEADS] + dt_bias_fwd.astype(jnp.float32))
    dt_b = jax.nn.softplus(dt_raw[..., SSD_HEADS:] + dt_bias_bwd.astype(jnp.float32))
    a_f = -jnp.exp(a_log_fwd.astype(jnp.float32))
    a_b = -jnp.exp(a_log_bwd.astype(jnp.float32))
    y_f = ssd_chunked(xs * dt_f[..., None], dt_f * a_f, bm, cm)
    flip = lambda t: jnp.flip(t, axis=1)
    y_b = flip(ssd_chunked(flip(xs * dt_b[..., None]), flip(dt_b * a_b), flip(bm), flip(cm)))
    y = y_f + y_b + d_skip.astype(jnp.float32)[:, None] * xs
    y = y.reshape(b, s, SSD_WIDTH) * jax.nn.silu(z.astype(jnp.float32))
    yg = y.reshape(b, s, SSD_GROUPS, SSD_WIDTH // SSD_GROUPS)
    yg = yg * lax.rsqrt(jnp.mean(jnp.square(yg), axis=-1, keepdims=True) + NORM_EPS)
    return yg.reshape(b, s, SSD_WIDTH) * norm_w.astype(jnp.float32)


def moe_ffn(x, router_w, router_b, w_gate, b_gate, w_up, b_up, w_down, b_down):
    b, s, d = x.shape
    xt = x.reshape(b * s, d)
    logits = (xt @ router_w + router_b).astype(jnp.float32)
    top_vals, top_idx = lax.top_k(logits, TOP_K)
    gates = jax.nn.softmax(top_vals, axis=-1)
    combine = jnp.sum(jax.nn.one_hot(top_idx, N_EXPERTS, dtype=jnp.float32) * gates[..., None], axis=1)
    out = jnp.zeros((b * s, d), dtype=jnp.float32)
    for e in range(N_EXPERTS):
        g = (xt @ w_gate[e] + b_gate[e]).astype(jnp.float32)
        u = (xt @ w_up[e] + b_up[e]).astype(jnp.float32)
        g = jnp.minimum(g, SWIGLU_LIMIT)
        u = jnp.clip(u, -SWIGLU_LIMIT, SWIGLU_LIMIT)
        act = (u + 1.0) * g * jax.nn.sigmoid(SWIGLU_ALPHA * g)
        y = act.astype(x.dtype) @ w_down[e] + b_down[e]
        out = out + combine[:, e:e + 1] * y.astype(jnp.float32)
    return out.reshape(b, s, d)


def setup_inputs(seed: int = 0) -> dict:
    key = jax.random.key(seed)
    ks = jax.random.split(key, 24)
    f32 = jnp.float32
    nrm = lambda k, shape, scale: jax.random.normal(k, shape, f32) * scale
    dt = jnp.exp(jax.random.uniform(ks[4], (DEPTH, SSD_HEADS), f32, math.log(1e-3), math.log(1e-1)))
    dt2 = jnp.exp(jax.random.uniform(ks[6], (DEPTH, SSD_HEADS), f32, math.log(1e-3), math.log(1e-1)))
    return {
        "x": jax.random.normal(ks[0], (BATCH, SEQ, D_MODEL), f32),
        "w_in": nrm(ks[1], (DEPTH, D_MODEL, IN_PROJ_COLS), D_MODEL ** -0.5),
        "attn_norm_w": 1.0 + nrm(ks[2], (DEPTH, ATTN_WIDTH), 0.02),
        "conv_w": nrm(ks[3], (DEPTH, SSD_CONV, SSD_CONV_CH), SSD_CONV ** -0.5),
        "conv_b": nrm(ks[21], (DEPTH, SSD_CONV_CH), 0.02),
        "dt_bias_fwd": dt + jnp.log(-jnp.expm1(-dt)),
        "a_log_fwd": jnp.log(jax.random.uniform(ks[5], (DEPTH, SSD_HEADS), f32, 1.0, 16.0)),
        "dt_bias_bwd": dt2 + jnp.log(-jnp.expm1(-dt2)),
        "a_log_bwd": jnp.log(jax.random.uniform(ks[7], (DEPTH, SSD_HEADS), f32, 1.0, 16.0)),
        "d_skip": 1.0 + nrm(ks[8], (DEPTH, SSD_HEADS), 0.1),
        "ssd_norm_w": 1.0 + nrm(ks[9], (DEPTH, SSD_WIDTH), 0.02),
        "w_out": nrm(ks[10], (DEPTH, D_MIX, D_MODEL), DEEPNORM_BETA * D_MIX ** -0.5),
        "ln1_w": 1.0 + nrm(ks[11], (DEPTH, D_MODEL), 0.02),
        "ln1_b": nrm(ks[12], (DEPTH, D_MODEL), 0.02),
        "router_w": nrm(ks[13], (DEPTH, D_MODEL, N_EXPERTS), D_MODEL ** -0.5),
        "router_b": nrm(ks[14], (DEPTH, N_EXPERTS), 0.01),
        "w_gate": nrm(ks[15], (DEPTH, N_EXPERTS, D_MODEL, D_EXPERT), D_MODEL ** -0.5),
        "b_gate": nrm(ks[16], (DEPTH, N_EXPERTS, D_EXPERT), 0.02),
        "w_up": nrm(ks[17], (DEPTH, N_EXPERTS, D_MODEL, D_EXPERT), D_MODEL ** -0.5),
        "b_up": nrm(ks[18], (DEPTH, N_EXPERTS, D_EXPERT), 0.02),
        "w_down": nrm(ks[19], (DEPTH, N_EXPERTS, D_EXPERT, D_MODEL), DEEPNORM_BETA * D_EXPERT ** -0.5),
        "b_down": nrm(ks[20], (DEPTH, N_EXPERTS, D_MODEL), 0.02),
        "ln2_w": 1.0 + nrm(ks[22], (DEPTH, D_MODEL), 0.02),
        "ln2_b": nrm(ks[23], (DEPTH, D_MODEL), 0.02),
    }


def reference(x, w_in, attn_norm_w, conv_w, conv_b, dt_bias_fwd, a_log_fwd, dt_bias_bwd,
              a_log_bwd, d_skip, ssd_norm_w, w_out, ln1_w, ln1_b, router_w, router_b,
              w_gate, b_gate, w_up, b_up, w_down, b_down, ln2_w, ln2_b):
    b, s, _ = x.shape
    cos, sin = rope_tables(s)
    h = x
    q_end = ATTN_WIDTH
    k_end = 2 * ATTN_WIDTH
    v_end = 3 * ATTN_WIDTH
    z_end = v_end + SSD_WIDTH
    xbc_end = z_end + SSD_CONV_CH
    for layer in range(DEPTH):
        proj = h @ w_in[layer]
        q = proj[..., :q_end].reshape(b, s, ATTN_HEADS, HEAD_DIM).astype(jnp.float32)
        k = proj[..., q_end:k_end].reshape(b, s, ATTN_HEADS, HEAD_DIM).astype(jnp.float32)
        v = proj[..., k_end:v_end].reshape(b, s, ATTN_HEADS, HEAD_DIM).astype(jnp.float32)
        attn = dilated_attention(apply_rope(q, cos, sin), apply_rope(k, cos, sin), v)
        attn = rms_norm(attn.reshape(b, s, ATTN_WIDTH), attn_norm_w[layer])
        ssd = bidirectional_ssd(proj[..., v_end:z_end], proj[..., z_end:xbc_end], proj[..., xbc_end:],
                                conv_w[layer], conv_b[layer], dt_bias_fwd[layer], a_log_fwd[layer],
                                dt_bias_bwd[layer], a_log_bwd[layer], d_skip[layer], ssd_norm_w[layer])
        mix = jnp.concatenate([attn, ssd], axis=-1).astype(h.dtype) @ w_out[layer]
        h1 = layer_norm(DEEPNORM_ALPHA * h.astype(jnp.float32) + mix.astype(jnp.float32),
                        ln1_w[layer], ln1_b[layer]).astype(x.dtype)
        ffn = moe_ffn(h1, router_w[layer], router_b[layer], w_gate[layer], b_gate[layer],
                      w_up[layer], b_up[layer], w_down[layer], b_down[layer])
        h = layer_norm(DEEPNORM_ALPHA * h1.astype(jnp.float32) + ffn,
                       ln2_w[layer], ln2_b[layer]).astype(x.dtype)
    return h
```

```cpp
#include <hip/hip_runtime.h>
#include <cstdio>
#include <cstdint>
#include <cmath>

#define LAS __attribute__((address_space(3)))
#define GAS __attribute__((address_space(1)))
typedef unsigned short bf16_t;
typedef short bf16x8 __attribute__((ext_vector_type(8)));
typedef float f32x4 __attribute__((ext_vector_type(4)));
typedef float f32x2 __attribute__((ext_vector_type(2)));
typedef unsigned u32x4 __attribute__((ext_vector_type(4)));
typedef unsigned u32x2 __attribute__((ext_vector_type(2)));

constexpr int BATCH = 8, SEQ = 4096, DM = 1024, NTOK = BATCH * SEQ;
constexpr int NH = 8, HD = 64;
constexpr int PROJW = 3072;
constexpr int COL_Q = 0, COL_K = 512, COL_V = 1024, COL_Z = 1536, COL_X = 2048;
constexpr int WIN_LD = 3088;
constexpr int NE = 32, TOPK = 4;
constexpr int MAXROWS = 139264;
constexpr float ALPHA = 1.18920711500272f;
constexpr float EPS = 1e-5f;
constexpr float F8_SCALE_H = 4.0f, F8_SCALE_W = 64.0f, F8_SCALE_A = 4.0f, F8_SCALE_D = 128.0f, F8_SCALE_Y = 16.0f;
constexpr int NWAVES = 8, NTHREADS = 512;

constexpr size_t MiB = 1u << 20;
constexpr size_t WS_CTL = 0, CTL_ZERO_BYTES = 1 * MiB;
constexpr size_t WS_ROPE = 1 * MiB;
constexpr size_t WS_WIN = 2 * MiB;
constexpr size_t WS_WOUT = 8 * MiB;
constexpr size_t WS_ROUTE = 10 * MiB;
constexpr size_t RT_TOPI = WS_ROUTE, RT_TOPG = WS_ROUTE + 512 * 1024, RT_BCNT = WS_ROUTE + 1024 * 1024, RT_SEGT = WS_ROUTE + 1056 * 1024;
constexpr size_t RT_TOKR = WS_ROUTE + 1088 * 1024, RT_GATR = RT_TOKR + 576 * 1024, RT_YROW = RT_GATR + 576 * 1024;
constexpr size_t RT_CD = WS_ROUTE + 4096 * 1024;
constexpr size_t WS_DT = 16 * MiB;
constexpr size_t WS_WGU = 18 * MiB;
constexpr size_t WS_XB = 82 * MiB;
constexpr size_t WS_H1F8 = 82 * MiB;
constexpr size_t WS_PROJ = 146 * MiB;
constexpr size_t WS_H1 = 290 * MiB;
constexpr size_t WS_XBC2 = 338 * MiB;
constexpr size_t WS_ATTO = 402 * MiB;
constexpr size_t WS_ML = 434 * MiB;
constexpr size_t WS_ACT = 354 * MiB;
constexpr size_t WS_Y = 18 * MiB;
constexpr size_t WS_WDN = 490 * MiB;
constexpr size_t WS_END = 522 * MiB;
static_assert(WS_Y + (size_t)MAXROWS * 2048 <= WS_H1 && WS_ACT + (size_t)MAXROWS * 1024 <= WS_WDN && WS_H1 + (size_t)NTOK * 2048 <= WS_ACT, "workspace map");
constexpr int CW_BAR = 4096;

constexpr int RING_BYTES = 131072;
constexpr int LDS_MISC = 155648;
constexpr int LDS_BYTES = 163840;
constexpr int LM_BAR = LDS_MISC + 0;
constexpr int LM_STEAL = LDS_MISC + 64;
constexpr int LM_HIST = LDS_MISC + 256;
constexpr int LM_SEGT = LDS_MISC + 512;
constexpr int LM_SEGC = LDS_MISC + 1024;
constexpr int LM_BASE = LDS_MISC + 1536;
constexpr int LM_PICK = LDS_MISC + 2048;
constexpr int LM_PTRS = LDS_MISC + 4096;
static_assert(LM_PTRS == 155648 + 4096 && LM_PTRS + 192 <= LDS_BYTES, "in_ptr() hard-codes this offset");

__device__ __forceinline__ unsigned f2bf(float f) { unsigned u = __float_as_uint(f); return (u + 0x7fffu + ((u >> 16) & 1u)) >> 16; }
__device__ __forceinline__ unsigned pk2(float lo, float hi) { return f2bf(lo) | (f2bf(hi) << 16); }
__device__ __forceinline__ float bflo(unsigned w) { return __uint_as_float(w << 16); }
__device__ __forceinline__ float bfhi(unsigned w) { return __uint_as_float(w & 0xffff0000u); }
__device__ __forceinline__ float bf2f(bf16_t b) { return __uint_as_float((unsigned)b << 16); }
__device__ __forceinline__ unsigned cvt_pk_bf16(float lo, float hi) { unsigned r; asm volatile("v_cvt_pk_bf16_f32 %0, %1, %2" : "=v"(r) : "v"(lo), "v"(hi)); return r; }
typedef __bf16 bf16x2_t __attribute__((ext_vector_type(2)));
__device__ __forceinline__ unsigned cvtpk(float lo, float hi) { f32x2 v = {lo, hi}; bf16x2_t b = __builtin_convertvector(v, bf16x2_t); return __builtin_bit_cast(unsigned, b); }
template <int M> __device__ __forceinline__ int lane_xor_i(int iv, int lane) {
    if constexpr (M == 1) return __builtin_amdgcn_update_dpp(0, iv, 0xB1, 0xF, 0xF, false);
    else if constexpr (M == 2) return __builtin_amdgcn_update_dpp(0, iv, 0x4E, 0xF, 0xF, false);
    else if constexpr (M == 4) { int t = __builtin_amdgcn_update_dpp(0, iv, 0x104, 0xF, 0x5, false); return __builtin_amdgcn_update_dpp(t, iv, 0x114, 0xF, 0xA, false); }
    else if constexpr (M == 8) return __builtin_amdgcn_update_dpp(0, iv, 0x128, 0xF, 0xF, false);
    else if constexpr (M == 16) { auto rr = __builtin_amdgcn_permlane16_swap((unsigned)iv, (unsigned)iv, false, false); return (int)((lane & 16) ? rr[0] : rr[1]); }
    else { auto rr = __builtin_amdgcn_permlane32_swap((unsigned)iv, (unsigned)iv, false, false); return (int)((lane & 32) ? rr[0] : rr[1]); }
}
template <int M> __device__ __forceinline__ float lane_xor_f(float v, int lane) { return __builtin_bit_cast(float, lane_xor_i<M>(__builtin_bit_cast(int, v), lane)); }
__device__ __forceinline__ float wave_sum(float v) {
    v += lane_xor_f<1>(v, 0); v += lane_xor_f<2>(v, 0); v += lane_xor_f<4>(v, 0); v += lane_xor_f<8>(v, 0);
    { auto rr = __builtin_amdgcn_permlane16_swap(__float_as_uint(v), __float_as_uint(v), false, false); v = __uint_as_float(rr[0]) + __uint_as_float(rr[1]); }
    { auto rr = __builtin_amdgcn_permlane32_swap(__float_as_uint(v), __float_as_uint(v), false, false); v = __uint_as_float(rr[0]) + __uint_as_float(rr[1]); }
    return v;
}
__device__ __forceinline__ float half_sum(float v) {
    v += lane_xor_f<1>(v, 0); v += lane_xor_f<2>(v, 0); v += lane_xor_f<4>(v, 0); v += lane_xor_f<8>(v, 0);
    { auto rr = __builtin_amdgcn_permlane16_swap(__float_as_uint(v), __float_as_uint(v), false, false); v = __uint_as_float(rr[0]) + __uint_as_float(rr[1]); }
    return v;
}
template <int M, int NH>
__device__ __forceinline__ void bfly_step(float* v, int lane) {
#pragma unroll
    for (int i = 0; i < NH; ++i) {
        if constexpr (M == 32) { auto rr = __builtin_amdgcn_permlane32_swap(__float_as_uint(v[i]), __float_as_uint(v[NH + i]), false, false); v[i] = __uint_as_float(rr[0]) + __uint_as_float(rr[1]); }
        else if constexpr (M == 16) { auto rr = __builtin_amdgcn_permlane16_swap(__float_as_uint(v[i]), __float_as_uint(v[NH + i]), false, false); v[i] = __uint_as_float(rr[0]) + __uint_as_float(rr[1]); }
        else { const float lo = v[i] + lane_xor_f<M>(v[i], lane), hi = v[NH + i] + lane_xor_f<M>(v[NH + i], lane); v[i] = (lane & M) ? hi : lo; }
    }
}
template <int N>
__device__ __forceinline__ void bfly_reduce(float (&v)[N], int lane) {
    static_assert(N == 8 || N == 16 || N == 32 || N == 64, "bfly_reduce sizes");
    if constexpr (N == 64) { bfly_step<32, 32>(v, lane); bfly_step<16, 16>(v, lane); bfly_step<8, 8>(v, lane); bfly_step<4, 4>(v, lane); bfly_step<2, 2>(v, lane); bfly_step<1, 1>(v, lane); }
    if constexpr (N == 32) { bfly_step<32, 16>(v, lane); bfly_step<16, 8>(v, lane); bfly_step<8, 4>(v, lane); bfly_step<4, 2>(v, lane); bfly_step<2, 1>(v, lane); v[0] += lane_xor_f<1>(v[0], lane); }
    if constexpr (N == 16) { bfly_step<32, 8>(v, lane); bfly_step<16, 4>(v, lane); bfly_step<8, 2>(v, lane); bfly_step<4, 1>(v, lane); v[0] += lane_xor_f<2>(v[0], lane); v[0] += lane_xor_f<1>(v[0], lane); }
    if constexpr (N == 8) { bfly_step<32, 4>(v, lane); bfly_step<16, 2>(v, lane); bfly_step<8, 1>(v, lane); v[0] += lane_xor_f<4>(v[0], lane); v[0] += lane_xor_f<2>(v[0], lane); v[0] += lane_xor_f<1>(v[0], lane); }
}
#define LDS_WAIT() asm volatile("s_waitcnt lgkmcnt(0)" ::: "memory")
__device__ __forceinline__ const float* in_ptr(LAS unsigned char* lds, int idx) {
    const unsigned long long v = ((const LAS unsigned long long*)(lds + 155648 + 4096))[idx];
    const unsigned lo = __builtin_amdgcn_readfirstlane((unsigned)v), hi = __builtin_amdgcn_readfirstlane((unsigned)(v >> 32));
    return (const float*)(const GAS float*)(((unsigned long long)hi << 32) | lo);
}
#define VM_WAIT() asm volatile("s_waitcnt vmcnt(0)" ::: "memory")

namespace pg8 {
constexpr int BM = 256, BK = 64, HALF = 128, HTB = HALF * BK * 2, STAGE_BYTES = 8 * HTB, NXCD = 8, WGM = 8, KD = 1024, NT = KD / BK;
__host__ __device__ __forceinline__ int lds_byte(int r, int c) { const int st = (r >> 4) * 2 + (c >> 5), rr = r & 15, cc = c & 31, ob = rr * 64 + cc * 2; return st * 1024 + (ob ^ (((ob >> 9) & 1) << 5)); }
__host__ __device__ __forceinline__ void stage_rc(int b, int& R, int& C) { const int st = b / 1024, sb = b % 1024, swz = sb ^ (((sb >> 9) & 1) << 5); R = (st >> 1) * 16 + swz / 64; C = (st & 1) * 32 + (swz % 64) / 2; }
__host__ __device__ __forceinline__ int perm32(int rho) { const int n = rho >> 4, i = rho & 15; return 8 * (i >> 2) + 4 * n + (i & 3); }

struct Unit { int arow0, pm, pn, aux, trow, nval; const char* bptr; };

struct StaticOrder {
    int nM, nN, nwg, G, c; const char* Bt;
    __device__ void init(int M, int N, int G_, int c_, const bf16_t* Bt_) { nM = M / BM; nN = N / BM; nwg = nM * nN; G = G_; c = c_; Bt = (const char*)Bt_; }
    __device__ bool next(int i, Unit& u) const {
        const long L = (long)i * G + c; if (L >= nwg) return false;
        int wgid = (int)L; { const int q = nwg / NXCD, r = nwg % NXCD, xcd = wgid % NXCD, off = wgid / NXCD; wgid = (xcd < r ? xcd * (q + 1) : r * (q + 1) + (xcd - r) * q) + off; }
        const int nig = WGM * nN, gid = wgid / nig, fm = gid * WGM, gsz = (nM - fm) < WGM ? (nM - fm) : WGM;
        u.pm = fm + ((wgid % nig) % gsz); u.pn = (wgid % nig) / gsz; u.arow0 = u.pm * BM; u.aux = 0; u.trow = 0; u.nval = 0; u.bptr = Bt + (size_t)u.pn * BM * KD * 2; return true;
    }
};
struct IdentityRows { __device__ __forceinline__ int row(const Unit& u, int r) const { return u.arow0 + r; } };
struct TableRows { const int* tab; __device__ __forceinline__ int row(const Unit& u, int r) const { return r < u.nval ? tab[u.trow + r] : 0; } };

typedef int v8i_t __attribute__((ext_vector_type(8)));
template <bool F8 = false, class Epi, class Sched, class RowMap>
__device__ __forceinline__ void gemm_phase(LAS unsigned char* lds, const void* Abase, const Sched& S, const RowMap& RM, const Epi& E) {
    constexpr int PITCH = F8 ? KD : KD * 2, NTK = F8 ? KD / 128 : KD / BK;
    int tid = threadIdx.x; asm volatile("" : "+v"(tid)); tid &= 511;
    const int wid = __builtin_amdgcn_readfirstlane(tid >> 6), lane = tid & 63, wr = wid >> 2, wc = wid & 3, fr = lane & 15, fq = lane >> 4;
    int Rr[2], Cc[2]; unsigned voffB[2];
#pragma unroll
    for (int i = 0; i < 2; ++i) { int R, C; stage_rc(tid * 16 + i * 8192, R, C); int Rb = Epi::PERM ? ((R & ~31) + perm32(R & 31)) : R;
        if constexpr (Epi::PERM16) Rb = 64 * (R >> 5) + 16 * ((R >> 2) & 3) + 4 * ((R >> 4) & 1) + (R & 3);
        Rr[i] = R; Cc[i] = C; voffB[i] = (unsigned)(Rb * PITCH + C * 2); }
    constexpr size_t kstep = (size_t)(BK * 2);
    constexpr size_t hstep = (size_t)(Epi::PERM16 ? 8 : HALF) * PITCH;
    const unsigned ldsw = (unsigned)wid * 1024u;
    const int aoff = F8 ? lds_byte(wr * 64 + fr, fq * 16) : lds_byte(wr * 64 + fr, fq * 8), boff = F8 ? lds_byte(wc * 32 + fr, fq * 16) : lds_byte(wc * 32 + fr, fq * 8);
    const int aoff1 = F8 ? lds_byte(wr * 64 + fr, fq * 16 + 8) : aoff + 1024, boff1 = F8 ? lds_byte(wc * 32 + fr, fq * 16 + 8) : boff + 1024;
    const unsigned lds0 = (unsigned)(unsigned long long)lds;
    unsigned abase0 = lds0 + (unsigned)aoff, bbase0 = lds0 + 65536u + (unsigned)boff;
    asm volatile("" : "+v"(abase0), "+v"(bbase0));
    const unsigned abase1 = abase0 + (F8 ? 16u : 1024u), bbase1 = bbase0 + (F8 ? 16u : 1024u); (void)aoff1; (void)boff1;
#define PG8_SA(b, h) (((b) * 2 + (h)) * HTB)
#define PG8_SB(b, h) ((4 + (b) * 2 + (h)) * HTB)
#define PG8_STAGE(bufoff, gbase, voff) do { _Pragma("unroll") for (int _i = 0; _i < 2; ++_i) { unsigned _keep; \
        asm volatile("s_mov_b32 %0, m0\n\ts_mov_b32 m0, %3\n\ts_nop 0\n\tglobal_load_lds_dwordx4 %1, %2\n\ts_mov_b32 m0, %0" : "=&s"(_keep) : "v"((voff)[_i]), "s"((const char*)(gbase)), \
                     "s"((unsigned)__builtin_amdgcn_readfirstlane((int)(unsigned)(unsigned long long)(lds + (bufoff) + ldsw + _i * 8192))) : "memory"); } } while (0)
#define PG8_RDA(base, off) (*(const LAS u32x4*)(size_t)((base) + (unsigned)(off)))
#define PG8_LDA(dst, b, h) do { _Pragma("unroll") for (int m = 0; m < 4; ++m) { if constexpr (F8) { const u32x4 _lo = PG8_RDA(abase0, PG8_SA(b, h) + m * 2048), _hi = PG8_RDA(abase1, PG8_SA(b, h) + m * 2048); \
        dst##8[m] = (v8i_t){(int)_lo.x, (int)_lo.y, (int)_lo.z, (int)_lo.w, (int)_hi.x, (int)_hi.y, (int)_hi.z, (int)_hi.w}; } \
        else { _Pragma("unroll") for (int k = 0; k < 2; ++k) dst[m][k] = __builtin_bit_cast(bf16x8, PG8_RDA(abase0, PG8_SA(b, h) + m * 2048 + k * 1024)); } } } while (0)
#define PG8_LDB(dst, b, h) do { _Pragma("unroll") for (int n = 0; n < 2; ++n) { if constexpr (F8) { const u32x4 _lo = PG8_RDA(bbase0, PG8_SB(b, h) - 65536 + n * 2048), _hi = PG8_RDA(bbase1, PG8_SB(b, h) - 65536 + n * 2048); \
        dst##8[n] = (v8i_t){(int)_lo.x, (int)_lo.y, (int)_lo.z, (int)_lo.w, (int)_hi.x, (int)_hi.y, (int)_hi.z, (int)_hi.w}; } \
        else { _Pragma("unroll") for (int k = 0; k < 2; ++k) dst[n][k] = __builtin_bit_cast(bf16x8, PG8_RDA(bbase0, PG8_SB(b, h) - 65536 + n * 2048 + k * 1024)); } } } while (0)
#define PG8_MMA(ai, bj, At, Bt) do { __builtin_amdgcn_s_setprio(1); _Pragma("unroll") for (int m = 0; m < 4; ++m) _Pragma("unroll") for (int n = 0; n < 2; ++n) { \
        if constexpr (F8) acc[ai][bj][m][n] = __builtin_amdgcn_mfma_scale_f32_16x16x128_f8f6f4(Bt##8[n], At##8[m], acc[ai][bj][m][n], 0, 0, 0, 0, 0, 0);     \
        else { _Pragma("unroll") for (int k = 0; k < 2; ++k) acc[ai][bj][m][n] = __builtin_amdgcn_mfma_f32_16x16x32_bf16(Bt[n][k], At[m][k], acc[ai][bj][m][n], 0, 0, 0); } } __builtin_amdgcn_s_setprio(0); } while (0)
#define PG8_WAIT_V(n) asm volatile("s_waitcnt vmcnt(" #n ")" ::: "memory")
#define PG8_WAIT_L(n) asm volatile("s_waitcnt lgkmcnt(" #n ")" ::: "memory")
#define PG8_BAR __builtin_amdgcn_s_barrier()
#define PG8_SCHED __builtin_amdgcn_sched_barrier(0)
#define PG8_ROWS(v, u) do { int _t = threadIdx.x; asm volatile("" : "+v"(_t)); _t &= 511; _Pragma("unroll") for (int _i = 0; _i < 2; ++_i) { int _R, _C; stage_rc(_t * 16 + _i * 8192, _R, _C); \
        _Pragma("unroll") for (int _h = 0; _h < 2; ++_h) v[_h][_i] = (unsigned)RM.row((u), _h * HALF + _R) * (unsigned)PITCH + (unsigned)_C * 2u; } } while (0)
    Unit cur, nxt; int ui = 0;
    if (!S.next(0, cur)) return;
    unsigned vc[2][2];
    PG8_ROWS(vc, cur);
#define PG8_VNSLOT ((LAS u32x4*)(lds + 131072) + (threadIdx.x & 511))
    f32x4 acc[2][2][4][2];
#pragma unroll
    for (int a = 0; a < 2; ++a)
#pragma unroll
        for (int b = 0; b < 2; ++b)
#pragma unroll
            for (int m = 0; m < 4; ++m)
#pragma unroll
                for (int n = 0; n < 2; ++n) acc[a][b][m][n] = (f32x4){0.f, 0.f, 0.f, 0.f};
    bf16x8 At[4][2], B0[2][2], B1[2][2]; v8i_t At8[4], B08[2], B18[2];
    const char* cA = (const char*)Abase; const char* cB = cur.bptr;
    PG8_STAGE(PG8_SB(0, 0), cB, voffB); PG8_STAGE(PG8_SB(0, 1), cB + hstep, voffB); PG8_STAGE(PG8_SA(0, 0), cA, vc[0]); PG8_STAGE(PG8_SA(0, 1), cA, vc[1]);
    if (wr == 1) PG8_BAR;
    PG8_WAIT_V(2); PG8_BAR;
    PG8_STAGE(PG8_SB(1, 0), cB + kstep, voffB); PG8_STAGE(PG8_SA(1, 0), cA + kstep, vc[0]); PG8_STAGE(PG8_SB(1, 1), cB + hstep + kstep, voffB);
    PG8_WAIT_V(6); PG8_BAR;
    for (;;) {
        const bool has_next = S.next(ui + 1, nxt);
        { unsigned vn[2][2];
          if (has_next) { PG8_ROWS(vn, nxt); } else {
#pragma unroll
            for (int h = 0; h < 2; ++h)
#pragma unroll
                for (int i = 0; i < 2; ++i) vn[h][i] = vc[h][i]; }
          *PG8_VNSLOT = (u32x4){vn[0][0], vn[0][1], vn[1][0], vn[1][1]}; }
        const char* nB = has_next ? nxt.bptr : cB;
#pragma unroll 1
        for (int t = 0; t < NTK; t += 2) {
            const bool last = (t == NTK - 2);
            const char* a1 = cA + (size_t)(t + 1) * kstep;
            const char* a2 = last ? cA : cA + (size_t)(t + 2) * kstep; const char* b2 = last ? nB : cB + (size_t)(t + 2) * kstep;
            const char* a3 = a2 + kstep; const char* b3 = b2 + kstep;

            PG8_LDB(B0, 0, 0); PG8_LDB(B1, 0, 1); PG8_SCHED; PG8_LDA(At, 0, 0); PG8_STAGE(PG8_SA(1, 1), a1, vc[1]);
            if (last) { const u32x4 q = *PG8_VNSLOT; vc[0][0] = q.x; vc[0][1] = q.y; vc[1][0] = q.z; vc[1][1] = q.w; }
            PG8_WAIT_V(8); PG8_WAIT_L(0); PG8_BAR; PG8_MMA(0, 0, At, B0); PG8_MMA(0, 1, At, B1); PG8_BAR; PG8_SCHED;
            PG8_LDA(At, 0, 1); PG8_STAGE(PG8_SB(0, 0), b2, voffB); PG8_STAGE(PG8_SB(0, 1), b2 + hstep, voffB); PG8_STAGE(PG8_SA(0, 0), a2, vc[0]);
            PG8_WAIT_V(8); PG8_WAIT_L(0); PG8_BAR; PG8_MMA(1, 0, At, B0); PG8_MMA(1, 1, At, B1); PG8_BAR; PG8_SCHED;
            PG8_LDB(B0, 1, 0); PG8_LDB(B1, 1, 1); PG8_SCHED; PG8_LDA(At, 1, 0); PG8_STAGE(PG8_SA(0, 1), a2, vc[1]);
            PG8_WAIT_V(8); PG8_WAIT_L(0); PG8_BAR; PG8_MMA(0, 0, At, B0); PG8_MMA(0, 1, At, B1); PG8_BAR; PG8_SCHED;
            PG8_LDA(At, 1, 1); PG8_STAGE(PG8_SB(1, 0), b3, voffB); PG8_STAGE(PG8_SB(1, 1), b3 + hstep, voffB); PG8_STAGE(PG8_SA(1, 0), a3, vc[0]);
            PG8_WAIT_V(8); PG8_WAIT_L(0); PG8_BAR; PG8_MMA(1, 0, At, B0); PG8_MMA(1, 1, At, B1); PG8_BAR; PG8_SCHED;
        }
        if (wr == 0) PG8_BAR;
        { int _t = threadIdx.x; asm volatile("" : "+v"(_t)); _t &= 511; const int _l = _t & 63; E(acc, cur, wr, wc, _l & 15, _l >> 4); }
        if (!has_next) break;
#pragma unroll
        for (int a = 0; a < 2; ++a)
#pragma unroll
            for (int b = 0; b < 2; ++b)
#pragma unroll
                for (int m = 0; m < 4; ++m)
#pragma unroll
                    for (int n = 0; n < 2; ++n) acc[a][b][m][n] = (f32x4){0.f, 0.f, 0.f, 0.f};
        cur = nxt; cB = nB; ++ui;
        if (wr == 1) PG8_BAR;
    }
    PG8_WAIT_V(0);
    PG8_BAR;
#undef PG8_SA
#undef PG8_SB
#undef PG8_STAGE
#undef PG8_LDA
#undef PG8_LDB
#undef PG8_MMA
#undef PG8_RDA
#undef PG8_WAIT_V
#undef PG8_WAIT_L
#undef PG8_BAR
#undef PG8_SCHED
#undef PG8_ROWS
#undef PG8_VNSLOT
}

struct EpiProj {
    static constexpr bool PERM = true, PERM16 = false;
    bf16_t* O; const f32x2* rope;
    __device__ __forceinline__ void operator()(const f32x4 (&acc)[2][2][4][2], const Unit& u, int wr, int wc, int fr, int fq) const {
        const int row0 = u.pm * BM + wr * 64 + fr, col0 = u.pn * BM + wc * 32 + 8 * fq;
        const bool rot = u.pn < 4; const float sc = u.pn < 2 ? 0.125f * 1.4426950408889634f : 1.0f;
        const int j0 = 16 * (wc & 1) + 4 * fq;
#pragma unroll
        for (int ai = 0; ai < 2; ++ai)
#pragma unroll
            for (int m = 0; m < 4; ++m) {
                const int row = row0 + ai * HALF + m * 16; bf16_t* rowp = O + (size_t)row * PROJW + col0;
                f32x4 cs0 = (f32x4){1.f, 0.f, 1.f, 0.f}, cs1 = cs0;
                if (rot) { const f32x4* rp = (const f32x4*)(rope + (size_t)(row & (SEQ - 1)) * 32 + j0); cs0 = rp[0]; cs1 = rp[1]; }
#pragma unroll
                for (int bj = 0; bj < 2; ++bj) {
                    f32x4 v0 = acc[ai][bj][m][0], v1 = acc[ai][bj][m][1];
                    if (rot) {
                        const f32x4 a = v0, b = v1;
                        v0[0] = a[0] * cs0[0] - a[1] * cs0[1]; v0[1] = a[1] * cs0[0] + a[0] * cs0[1];
                        v0[2] = a[2] * cs0[2] - a[3] * cs0[3]; v0[3] = a[3] * cs0[2] + a[2] * cs0[3];
                        v1[0] = b[0] * cs1[0] - b[1] * cs1[1]; v1[1] = b[1] * cs1[0] + b[0] * cs1[1];
                        v1[2] = b[2] * cs1[2] - b[3] * cs1[3]; v1[3] = b[3] * cs1[2] + b[2] * cs1[3];
                    }
                    v0 = v0 * sc; v1 = v1 * sc;
                    u32x4 w; w.x = cvt_pk_bf16(v0[0], v0[1]); w.y = cvt_pk_bf16(v0[2], v0[3]); w.z = cvt_pk_bf16(v1[0], v1[1]); w.w = cvt_pk_bf16(v1[2], v1[3]);
                    *(u32x4*)(rowp + bj * HALF) = w; }
            }
    }
};
struct EpiOut {
    static constexpr bool PERM = true, PERM16 = false;
    const bf16_t* X; bf16_t* O;
    __device__ __forceinline__ void operator()(const f32x4 (&acc)[2][2][4][2], const Unit& u, int wr, int wc, int fr, int fq) const {
        const int col0 = u.pn * BM + wc * 32 + 8 * fq;
#pragma unroll
        for (int ai = 0; ai < 2; ++ai)
#pragma unroll
            for (int m = 0; m < 4; ++m) { const size_t off = (size_t)(u.pm * BM + ai * HALF + wr * 64 + m * 16 + fr) * DM + col0;
#pragma unroll
                for (int bj = 0; bj < 2; ++bj) { const u32x4 xw = *(const u32x4*)(X + off + bj * HALF);
                    const f32x4 x0 = (f32x4){bflo(xw.x), bfhi(xw.x), bflo(xw.y), bfhi(xw.y)}, x1 = (f32x4){bflo(xw.z), bfhi(xw.z), bflo(xw.w), bfhi(xw.w)};
                    const f32x4 v0 = x0 * ALPHA + acc[ai][bj][m][0], v1 = x1 * ALPHA + acc[ai][bj][m][1];
                    u32x4 w; w.x = cvt_pk_bf16(v0[0], v0[1]); w.y = cvt_pk_bf16(v0[2], v0[3]); w.z = cvt_pk_bf16(v1[0], v1[1]); w.w = cvt_pk_bf16(v1[2], v1[3]);
                    *(u32x4*)(O + off + bj * HALF) = w; } }
    }
};
struct EpiAct {
    static constexpr bool PERM = true, PERM16 = false;
    unsigned char* O; const float* bg; const float* bu; float osc;
    __device__ __forceinline__ void operator()(const f32x4 (&acc)[2][2][4][2], const Unit& u, int wr, int wc, int fr, int fq) const {
        const int ec0 = u.pn * HALF + wc * 32 + 8 * fq;
        const float* bgp = bg + u.aux * 1024 + ec0; const float* bup = bu + u.aux * 1024 + ec0;
        const f32x4 g0b = *(const f32x4*)bgp, g1b = *(const f32x4*)(bgp + 4), u0b = *(const f32x4*)bup, u1b = *(const f32x4*)(bup + 4);
#pragma unroll
        for (int ai = 0; ai < 2; ++ai)
#pragma unroll
            for (int m = 0; m < 4; ++m) {
                const int row = u.pm * BM + ai * HALF + wr * 64 + m * 16 + fr;
                const f32x4 g[2] = {acc[ai][0][m][0] * osc + g0b, acc[ai][0][m][1] * osc + g1b}, uu[2] = {acc[ai][1][m][0] * osc + u0b, acc[ai][1][m][1] * osc + u1b}; float r[8];
#pragma unroll
                for (int n = 0; n < 2; ++n)
#pragma unroll
                    for (int e = 0; e < 4; e += 2) {
                        const f32x2 gv = (f32x2){fminf(g[n][e], 7.0f), fminf(g[n][e + 1], 7.0f)};
                        const f32x2 uv = (f32x2){__builtin_amdgcn_fmed3f(uu[n][e], -7.0f, 7.0f), __builtin_amdgcn_fmed3f(uu[n][e + 1], -7.0f, 7.0f)};
                        const f32x2 t2 = gv * (-1.702f * 1.4426950408889634f);
                        const f32x2 d2 = (f32x2){__builtin_amdgcn_exp2f(t2[0]), __builtin_amdgcn_exp2f(t2[1])} + 1.0f;
                        const f32x2 r2 = (f32x2){__builtin_amdgcn_rcpf(d2[0]), __builtin_amdgcn_rcpf(d2[1])};
                        const f32x2 o2 = __builtin_elementwise_fma(uv, (f32x2){F8_SCALE_A, F8_SCALE_A}, (f32x2){F8_SCALE_A, F8_SCALE_A}) * (gv * r2);
                        r[4 * n + e] = o2[0]; r[4 * n + e + 1] = o2[1]; }
                int lo = __builtin_amdgcn_cvt_pk_fp8_f32(r[0], r[1], 0, false); lo = __builtin_amdgcn_cvt_pk_fp8_f32(r[2], r[3], lo, true);
                int hi = __builtin_amdgcn_cvt_pk_fp8_f32(r[4], r[5], 0, false); hi = __builtin_amdgcn_cvt_pk_fp8_f32(r[6], r[7], hi, true);
                *(u32x2*)(O + (size_t)row * 1024 + ec0) = (u32x2){(unsigned)lo, (unsigned)hi};
            }
    }
};
struct EpiY {
    static constexpr bool PERM = false, PERM16 = true;
    unsigned char* O; const float* bd; float osc;
    __device__ __forceinline__ void operator()(const f32x4 (&acc)[2][2][4][2], const Unit& u, int wr, int wc, int fr, int fq) const {
        const int col0 = u.pn * BM + wc * 64 + 16 * fq; const float* bp = bd + u.aux * 1024 + col0;
        f32x4 bv[2][2];
#pragma unroll
        for (int bj = 0; bj < 2; ++bj)
#pragma unroll
            for (int n = 0; n < 2; ++n) bv[bj][n] = *(const f32x4*)(bp + 8 * bj + 4 * n) * F8_SCALE_Y;
        const float os = osc * F8_SCALE_Y;
#pragma unroll
        for (int ai = 0; ai < 2; ++ai)
#pragma unroll
            for (int m = 0; m < 4; ++m) { unsigned char* rowp = O + (size_t)(u.pm * BM + ai * HALF + wr * 64 + m * 16 + fr) * 1024 + col0; u32x4 w;
#pragma unroll
                for (int bj = 0; bj < 2; ++bj) { f32x4 v0 = acc[ai][bj][m][0] * os + bv[bj][0], v1 = acc[ai][bj][m][1] * os + bv[bj][1];
#pragma unroll
                    for (int e = 0; e < 4; ++e) { v0[e] = __builtin_amdgcn_fmed3f(v0[e], -448.0f, 448.0f); v1[e] = __builtin_amdgcn_fmed3f(v1[e], -448.0f, 448.0f); }
                    int lo = __builtin_amdgcn_cvt_pk_fp8_f32(v0[0], v0[1], 0, false); lo = __builtin_amdgcn_cvt_pk_fp8_f32(v0[2], v0[3], lo, true);
                    int hi = __builtin_amdgcn_cvt_pk_fp8_f32(v1[0], v1[1], 0, false); hi = __builtin_amdgcn_cvt_pk_fp8_f32(v1[2], v1[3], hi, true);
                    if (bj == 0) { w.x = (unsigned)lo; w.y = (unsigned)hi; } else { w.z = (unsigned)lo; w.w = (unsigned)hi; } }
                *(u32x4*)rowp = w; }
    }
};
struct GroupedOrder {
    int t_lo, ntiles, npn, G, c, seg0; const LAS int* segt; const LAS int* segc; const char* W; size_t estride; int pitch;
    mutable int hint;
    __device__ bool next(int i, Unit& u) const {
        const int L = __builtin_amdgcn_readfirstlane(i * G + c); if (L >= ntiles * npn) return false;
        const int tile = t_lo + L / npn, pn = L % npn;
        int s = hint; while (s < seg0 + 31 && segt[s + 1] <= tile) ++s;
        hint = s;
        u.pm = tile - t_lo; u.pn = pn; u.aux = s & 31; u.arow0 = u.pm * BM; { const int ti = tile - segt[s]; u.trow = (s & 31) * NTOK + ti * BM; u.nval = segc[s & 31] - ti * BM; } u.bptr = W + (size_t)(s & 31) * estride + (size_t)pn * BM * pitch; return true;
    }
};
}


typedef short s16x4 __attribute__((ext_vector_type(4)));
typedef short v4i16_t __attribute__((ext_vector_type(4)));
typedef float f32x16 __attribute__((ext_vector_type(16)));
__device__ __forceinline__ s16x4 vtr(const LAS unsigned char* p) { return __builtin_bit_cast(s16x4, __builtin_amdgcn_ds_read_tr16_b64_v4i16((LAS v4i16_t*)p)); }
__device__ __forceinline__ int crow(int r, int hi) { return (r & 3) + 8 * (r >> 2) + 4 * hi; }
constexpr int ATT_VROW = 144;
constexpr int ATT_WLDS = 32 * ATT_VROW + 512;
constexpr int ATT_KBUF = 384 * 128, ATT_V0 = 2 * ATT_KBUF;
static_assert(ATT_V0 + NWAVES * ATT_WLDS <= LDS_MISC, "attention LDS map");
template <int DIL>
__device__ __forceinline__ void attn_kdma(const bf16_t* PROJ, int R, LAS unsigned char* kbuf, int wave, int lane) {
    constexpr int L = SEQ / DIL, TPR = L / 32;
    asm volatile("" : "+v"(lane));
    const int idx0 = 8 * R, bh = idx0 >> 7, w0 = idx0 & 127, b = bh >> 3, h = bh & 7, r = w0 / TPR, M0 = 32 * (w0 % TPR);
#pragma unroll
    for (int n = 0; n < 6; ++n) {
        const int row = 8 * (6 * wave + n) + (lane >> 3); int pos = M0 - 64 + row; pos = pos < 0 ? 0 : (pos > L - 1 ? L - 1 : pos);
        const unsigned voff = ((unsigned)(b * SEQ + pos * DIL + r) * PROJW + COL_K + h * 64) * 2u + (unsigned)(((lane & 7) ^ (lane >> 3)) * 16);
        unsigned keep;
        asm volatile("s_mov_b32 %0, m0\n\ts_mov_b32 m0, %3\n\ts_nop 0\n\tglobal_load_lds_dwordx4 %1, %2\n\ts_mov_b32 m0, %0" : "=&s"(keep) : "v"(voff), "s"((const char*)PROJ),
                     "s"((unsigned)__builtin_amdgcn_readfirstlane((int)(unsigned)(unsigned long long)(kbuf + (6 * wave + n) * 1024))) : "memory"); }
}
template <int DIL>
__device__ __forceinline__ void attn_qload(const bf16_t* PROJ, int idx, int lane, bf16x8 (&q)[4]) {
    constexpr int TPR = SEQ / DIL / 32;
    const int bh = idx >> 7, w = idx & 127, b = bh >> 3, h = bh & 7, r = w / TPR, m0 = 32 * (w % TPR), i = lane & 31, hi = lane >> 5;
    const unsigned qo = ((unsigned)(b * SEQ + (m0 + i) * DIL + r) * PROJW + COL_Q + h * 64 + 8 * hi) * 2u;
#pragma unroll
    for (int s = 0; s < 4; ++s) q[s] = *(const bf16x8*)((const char*)PROJ + qo + 32 * s);
}
template <int DIL, bool FIRST>
__device__ __forceinline__ void attn_task(bf16_t* PROJ, bf16_t* ATTO, float* ML, int b, int h, int r, int m0, LAS unsigned char* wl, const LAS unsigned char* kr, const bf16x8 (&qf)[4], int lane) {
    constexpr int L = SEQ / DIL;
    asm volatile("" : "+v"(lane)); lane &= 63;
    const int i = lane & 31, hi = lane >> 5;
    const char* PB = (const char*)PROJ;
    const unsigned tokq = (unsigned)(b * SEQ + (m0 + i) * DIL + r);
    const LAS unsigned char* krow = kr + i * 128;
    float* mlp = (float*)((char*)ML + (tokq * NH + h) * 8u);
    float mp = 0.f, lp = 0.f;
    if (!FIRST) { mp = mlp[0]; lp = mlp[1]; }
    f32x16 S[5];
#pragma unroll
    for (int kb = 0; kb < 5; ++kb) {
        const int mk0 = m0 - 64 + 32 * kb; const bool inr = (mk0 >= 0 && mk0 < L);
        f32x16 acc;
#pragma unroll
        for (int rr = 0; rr < 16; ++rr) acc[rr] = 0.f;
#pragma unroll
        for (int s = 0; s < 4; ++s) { const bf16x8 kf = *(const LAS bf16x8*)(krow + kb * 4096 + (((2 * s + hi) ^ (i & 7)) * 16)); acc = __builtin_amdgcn_mfma_f32_32x32x16_bf16(kf, qf[s], acc, 0, 0, 0); }
        if (kb == 0 || kb == 4) {
#pragma unroll
            for (int rr = 0; rr < 16; ++rr) { const bool ok = inr && (kb == 0 ? (crow(rr, hi) >= i) : (crow(rr, hi) <= i)); S[kb][rr] = ok ? acc[rr] : -INFINITY; }
        } else {
#pragma unroll
            for (int rr = 0; rr < 16; ++rr) S[kb][rr] = inr ? acc[rr] : -INFINITY; }
    }
    u32x4 vr[5][4];
#define ATT_VLOAD(kb) do { const int mk0_ = m0 - 64 + 32 * (kb), mkc_ = mk0_ < 0 ? 0 : (mk0_ > L - 32 ? L - 32 : mk0_); \
        _Pragma("unroll") for (int ii = 0; ii < 4; ++ii) { const int key = (lane >> 3) + 8 * ii; \
            vr[kb][ii] = *(const u32x4*)(PB + ((unsigned)(b * SEQ + (mkc_ + key) * DIL + r) * PROJW + COL_V + h * 64 + 8 * (lane & 7)) * 2u); } } while (0)
    ATT_VLOAD(0); ATT_VLOAD(1);
    char* OB = (char*)ATTO; const unsigned oo = ((unsigned)(b * SEQ + m0 * DIL + r) * 512 + h * 64 + i) * 2u;
    unsigned short pv0[16], pv1[16];
    if (!FIRST) {
#pragma unroll
        for (int rr = 0; rr < 16; ++rr) { const unsigned short* op = (const unsigned short*)(OB + oo + (unsigned)(crow(rr, hi) * DIL * 1024)); pv0[rr] = op[0]; pv1[rr] = op[32]; } }
    float mx = -INFINITY;
#pragma unroll
    for (int kb = 0; kb < 5; ++kb)
#pragma unroll
        for (int rr = 0; rr < 16; ++rr) mx = fmaxf(mx, S[kb][rr]);
    mx = fmaxf(mx, lane_xor_f<32>(mx, lane));
    float lsum = 0.f;
#pragma unroll
    for (int kb = 0; kb < 5; ++kb)
#pragma unroll
        for (int rr = 0; rr < 16; ++rr) { const float pv = __builtin_amdgcn_exp2f(S[kb][rr] - mx); S[kb][rr] = pv; lsum += pv; }
    lsum += lane_xor_f<32>(lsum, lane);
    f32x16 O[2];
#pragma unroll
    for (int rr = 0; rr < 16; ++rr) { O[0][rr] = 0.f; O[1][rr] = 0.f; }
    const int q4 = (lane & 15) >> 2, p4 = lane & 3, blk = (lane >> 4) & 1;
    const LAS unsigned char* vrd = wl + (4 * hi + q4) * ATT_VROW + (16 * blk + 4 * p4) * 2;
#pragma unroll
    for (int kb = 0; kb < 5; ++kb) {
#pragma unroll
        for (int ii = 0; ii < 4; ++ii) { const int key = (lane >> 3) + 8 * ii; *(LAS u32x4*)(wl + key * ATT_VROW + (lane & 7) * 16) = vr[kb][ii]; }
        if (kb == 0) ATT_VLOAD(2);
        if (kb == 1) ATT_VLOAD(3);
        if (kb == 2) ATT_VLOAD(4);
#pragma unroll
        for (int s = 0; s < 2; ++s) {
            u32x4 pw; pw.x = cvtpk(S[kb][8 * s], S[kb][8 * s + 1]); pw.y = cvtpk(S[kb][8 * s + 2], S[kb][8 * s + 3]); pw.z = cvtpk(S[kb][8 * s + 4], S[kb][8 * s + 5]); pw.w = cvtpk(S[kb][8 * s + 6], S[kb][8 * s + 7]);
            const bf16x8 pa = __builtin_bit_cast(bf16x8, pw);
#pragma unroll
            for (int dh = 0; dh < 2; ++dh) {
                const s16x4 lo = vtr(vrd + (16 * s) * ATT_VROW + 64 * dh), hh = vtr(vrd + (16 * s + 8) * ATT_VROW + 64 * dh);
                const bf16x8 vf = (bf16x8){lo[0], lo[1], lo[2], lo[3], hh[0], hh[1], hh[2], hh[3]};
                O[dh] = __builtin_amdgcn_mfma_f32_32x32x16_bf16(pa, vf, O[dh], 0, 0, 0);
            }
        }
    }
#undef ATT_VLOAD
    float fprev = 0.f, fcur;
    if (FIRST) { fcur = 1.0f / lsum; if (hi == 0) { mlp[0] = mx; mlp[1] = lsum; } }
    else { const float mn = fmaxf(mp, mx); const float aa = __builtin_amdgcn_exp2f(mp - mn) * lp, cc = __builtin_amdgcn_exp2f(mx - mn);
        const float ln = aa + cc * lsum; const float il = 1.0f / ln; fprev = aa * il; fcur = cc * il; if (hi == 0) { mlp[0] = mn; mlp[1] = ln; } }
    LAS float* sc = (LAS float*)(wl + 32 * ATT_VROW);
    if (hi == 0) { sc[i] = fprev; sc[32 + i] = fcur; }
    asm volatile("s_waitcnt lgkmcnt(0)" ::: "memory");
#pragma unroll
    for (int rr = 0; rr < 16; ++rr) { const int q = crow(rr, hi); const float fc = sc[32 + q]; bf16_t* op = (bf16_t*)(OB + oo + (unsigned)(q * DIL * 1024));
        float v0 = O[0][rr] * fc, v1 = O[1][rr] * fc;
        if (!FIRST) { const float fp = sc[q]; v0 += __uint_as_float((unsigned)pv0[rr] << 16) * fp; v1 += __uint_as_float((unsigned)pv1[rr] << 16) * fp; }
        op[0] = (bf16_t)f2bf(v0); op[32] = (bf16_t)f2bf(v1); }
    asm volatile("s_waitcnt lgkmcnt(0)" ::: "memory");
}
template <int DIL, bool FIRST>
__device__ __forceinline__ void attn_pass(bf16_t* PROJ, bf16_t* ATTO, float* ML, LAS unsigned char* lds, int vcu, int G, int wave, int lane) {
    constexpr int TPR = SEQ / DIL / 32;
    constexpr int NROUND = BATCH * NH * 128 / 8;
    const int per = (NROUND + G - 1) / G, R0 = vcu * per, R1 = (R0 + per < NROUND) ? R0 + per : NROUND;
    if (R0 >= R1) return;
    LAS unsigned char* wl = lds + ATT_V0 + wave * ATT_WLDS;
    __syncthreads();
    attn_kdma<DIL>(PROJ, R0, lds, wave, lane);
    bf16x8 qn[4]; attn_qload<DIL>(PROJ, 8 * R0 + wave, lane, qn);
    asm volatile("s_waitcnt vmcnt(0)" ::: "memory");
    for (int R = R0; R < R1; ++R) {
        __builtin_amdgcn_s_barrier();
        bf16x8 qf[4];
#pragma unroll
        for (int s = 0; s < 4; ++s) qf[s] = qn[s];
        if (R + 1 < R1) { attn_kdma<DIL>(PROJ, R + 1, lds + ((R + 1 - R0) & 1) * ATT_KBUF, wave, lane); attn_qload<DIL>(PROJ, 8 * (R + 1) + wave, lane, qn); }
        const int idx = 8 * R + wave, bh = idx >> 7, w = idx & 127;
        attn_task<DIL, FIRST>(PROJ, ATTO, ML, bh >> 3, bh & 7, w / TPR, 32 * (w % TPR), wl, lds + ((R - R0) & 1) * ATT_KBUF + (32 * wave) * 128, qf, lane); }
    __syncthreads();
}


constexpr int SSD_RS = 272, SSD_RSX = 528;
constexpr int SL_C = 0, SL_B = 34816, SL_X = 69632, SL_TAB = 137216;
static_assert(SL_TAB + 8192 <= LDS_MISC, "SSD LDS map");
__device__ __forceinline__ float bfx(short v) { return __uint_as_float((unsigned)(unsigned short)v << 16); }
__device__ __forceinline__ bf16x8 frag_tr(const LAS unsigned char* img, int RS, int k0, int n0, int lane) {
    const int h2 = lane >> 5, blk = (lane >> 4) & 1, q4 = (lane & 15) >> 2, p4 = lane & 3;
    const LAS unsigned char* p = img + (k0 + 8 * h2 + q4) * RS + (n0 + 16 * blk + 4 * p4) * 2;
    const s16x4 lo = vtr(p), hi = vtr(p + 4 * RS);
    return (bf16x8){lo[0], lo[1], lo[2], lo[3], hi[0], hi[1], hi[2], hi[3]};
}
__device__ __forceinline__ bf16x8 frag_row(const LAS unsigned char* img, int RS, int r0, int k0, int lane) {
    return *(const LAS bf16x8*)(img + (r0 + (lane & 31)) * RS + (k0 + 8 * (lane >> 5)) * 2);
}
__device__ __forceinline__ float ssd_stage(const bf16_t* XBC2, const float* DT, const float* alog_f, const float* alog_b, const float* dtb_f, const float* dtb_b,
                                           int b, int c, int g, bool needC, LAS unsigned char* lds, int tid, int wave, int lane) {
    const size_t t0 = (size_t)b * SEQ + 128 * c;
    {
        const char* XB = (const char*)XBC2 + t0 * 2048;
        u32x4 vb[4], vc[4], vx[8];
#pragma unroll
        for (int k = 0; k < 4; ++k) { const int i = tid + k * NTHREADS, row = i >> 4, pc = i & 15;
            vb[k] = *(const u32x4*)(XB + (unsigned)(row * 2048 + (512 + 128 * g + 8 * pc) * 2));
            if (needC) vc[k] = *(const u32x4*)(XB + (unsigned)(row * 2048 + (768 + 128 * g + 8 * pc) * 2)); }
#pragma unroll
        for (int k = 0; k < 8; ++k) { const int i = tid + k * NTHREADS, row = i >> 5, pc = i & 31; vx[k] = *(const u32x4*)(XB + (unsigned)(row * 2048 + (256 * g + 8 * pc) * 2)); }
#pragma unroll
        for (int k = 0; k < 4; ++k) { const int i = tid + k * NTHREADS, row = i >> 4, pc = i & 15;
            *(LAS u32x4*)(lds + SL_B + row * SSD_RS + pc * 16) = vb[k];
            if (needC) *(LAS u32x4*)(lds + SL_C + row * SSD_RS + pc * 16) = vc[k]; }
#pragma unroll
        for (int k = 0; k < 8; ++k) { const int i = tid + k * NTHREADS, row = i >> 5, pc = i & 31; *(LAS u32x4*)(lds + SL_X + row * SSD_RSX + pc * 16) = vx[k]; }
    }
    const int hh = wave & 3, dir = wave >> 2, h = 4 * g + hh;
    const float A = -expf(dir ? alog_b[h] : alog_f[h]), bias = dir ? dtb_b[h] : dtb_f[h];
    const int s0 = 2 * lane;
    const float r0 = DT[(t0 + s0) * 16 + dir * 8 + h] + bias, r1 = DT[(t0 + s0 + 1) * 16 + dir * 8 + h] + bias;
    const float d0 = r0 > 20.f ? r0 : log1pf(expf(r0)), d1 = r1 > 20.f ? r1 : log1pf(expf(r1));
    const float a0 = d0 * A, a1 = d1 * A, ps = a0 + a1;
    float x = ps;
#pragma unroll
    for (int off = 1; off < 64; off <<= 1) { const float y = __shfl_up(x, off); if (lane >= off) x += y; }
    const float total = __shfl(x, 63), excl = x - ps;
    LAS float* tab = (LAS float*)(lds + SL_TAB + wave * 1024);
    tab[s0] = dir ? total - excl : excl + a0; tab[s0 + 1] = dir ? total - (excl + a0) : x;
    tab[128 + s0] = d0; tab[128 + s0 + 1] = d1;
    return total;
}
__device__ __forceinline__ void ssd_pass_a(const bf16_t* XBC2, const float* DT, bf16_t* ST, float* CD, const float* alog_f, const float* alog_b, const float* dtb_f, const float* dtb_b,
                                           LAS unsigned char* lds, int vcu, int G, int tid, int wave, int lane) {
    for (int unit = vcu; unit < BATCH * 32 * 2; unit += G) {
        const int g = unit & 1, c = (unit >> 1) & 31, b = unit >> 6;
        const float total = ssd_stage(XBC2, DT, alog_f, alog_b, dtb_f, dtb_b, b, c, g, false, lds, tid, wave, lane);
        __syncthreads();
        const int hh = wave & 3, dir = wave >> 2, h = 4 * g + hh, h2 = lane >> 5, hi = h2;
        const size_t sidx = (((size_t)b * 32 + c) * 2 + dir) * 8 + h;
        if (lane == 0) CD[sidx] = expf(total);
        const LAS float* cs = (const LAS float*)(lds + SL_TAB + wave * 1024); const LAS float* dtv = cs + 128;
        f32x16 acc[4][2];
#pragma unroll
        for (int nt = 0; nt < 4; ++nt)
#pragma unroll
            for (int pt = 0; pt < 2; ++pt)
#pragma unroll
                for (int rr = 0; rr < 16; ++rr) acc[nt][pt][rr] = 0.f;
#pragma unroll 2
        for (int ks = 0; ks < 8; ++ks) {
            const f32x4 c0 = *(const LAS f32x4*)(cs + 16 * ks + 8 * h2), c1 = *(const LAS f32x4*)(cs + 16 * ks + 8 * h2 + 4);
            const f32x4 e0 = *(const LAS f32x4*)(dtv + 16 * ks + 8 * h2), e1 = *(const LAS f32x4*)(dtv + 16 * ks + 8 * h2 + 4);
            float sc[8];
#pragma unroll
            for (int j = 0; j < 4; ++j) { sc[j] = e0[j] * __expf(total - c0[j]); sc[4 + j] = e1[j] * __expf(total - c1[j]); }
            bf16x8 xf[2];
#pragma unroll
            for (int pt = 0; pt < 2; ++pt) { const bf16x8 raw = frag_tr(lds + SL_X, SSD_RSX, 16 * ks, 64 * hh + 32 * pt, lane);
                u32x4 w; w.x = cvtpk(bfx(raw[0]) * sc[0], bfx(raw[1]) * sc[1]); w.y = cvtpk(bfx(raw[2]) * sc[2], bfx(raw[3]) * sc[3]); w.z = cvtpk(bfx(raw[4]) * sc[4], bfx(raw[5]) * sc[5]); w.w = cvtpk(bfx(raw[6]) * sc[6], bfx(raw[7]) * sc[7]);
                xf[pt] = __builtin_bit_cast(bf16x8, w); }
#pragma unroll
            for (int nt = 0; nt < 4; ++nt) { const bf16x8 af = frag_tr(lds + SL_B, SSD_RS, 16 * ks, 32 * nt, lane);
#pragma unroll
                for (int pt = 0; pt < 2; ++pt) acc[nt][pt] = __builtin_amdgcn_mfma_f32_32x32x16_bf16(af, xf[pt], acc[nt][pt], 0, 0, 0); }
        }
        bf16_t* sp = ST + sidx * 8192;
#pragma unroll
        for (int nt = 0; nt < 4; ++nt)
#pragma unroll
            for (int pt = 0; pt < 2; ++pt)
#pragma unroll
                for (int rg = 0; rg < 4; ++rg) { u32x2 w; w.x = cvtpk(acc[nt][pt][4 * rg], acc[nt][pt][4 * rg + 1]); w.y = cvtpk(acc[nt][pt][4 * rg + 2], acc[nt][pt][4 * rg + 3]);
                    *(u32x2*)(sp + (32 * pt + (lane & 31)) * 128 + 32 * nt + 8 * rg + 4 * hi) = w; }
        __syncthreads();
    }
}
__device__ __forceinline__ void ssd_pass_b(bf16_t* ST, const float* CD, int gtid, int nthreads) {
    for (int idx = gtid; idx < BATCH * 2 * 8 * 64 * 16; idx += nthreads) {
        const int n8 = idx & 15, p = (idx >> 4) & 63, h = (idx >> 10) & 7, dir = (idx >> 13) & 1, b = idx >> 14;
        const size_t cstride = (size_t)2 * 8 * 8192;
        bf16_t* base = ST + (((size_t)b * 32 * 2 + dir) * 8 + h) * 8192 + p * 128 + 8 * n8;
        const float* cdb = CD + ((size_t)b * 32 * 2 + dir) * 8 + h;
        float run[8];
#pragma unroll
        for (int e = 0; e < 8; ++e) run[e] = 0.f;
#pragma unroll 1
        for (int half = 0; half < 2; ++half) {
            u32x4 w[16]; float dec[16];
#pragma unroll
            for (int i = 0; i < 16; ++i) { const int c = dir ? 31 - (16 * half + i) : 16 * half + i; w[i] = *(const u32x4*)(base + c * cstride); dec[i] = cdb[c * 16]; }
#pragma unroll
            for (int i = 0; i < 16; ++i) { const int c = dir ? 31 - (16 * half + i) : 16 * half + i;
                u32x4 o; o.x = cvtpk(run[0], run[1]); o.y = cvtpk(run[2], run[3]); o.z = cvtpk(run[4], run[5]); o.w = cvtpk(run[6], run[7]); *(u32x4*)(base + c * cstride) = o;
                const float d = dec[i]; run[0] = run[0] * d + bflo(w[i].x); run[1] = run[1] * d + bfhi(w[i].x); run[2] = run[2] * d + bflo(w[i].y); run[3] = run[3] * d + bfhi(w[i].y);
                run[4] = run[4] * d + bflo(w[i].z); run[5] = run[5] * d + bfhi(w[i].z); run[6] = run[6] * d + bflo(w[i].w); run[7] = run[7] * d + bfhi(w[i].w); }
        }
    }
}
constexpr int SSD_RSY = 1040;
__device__ __forceinline__ void ssd_pass_c(const bf16_t* XBC2, const float* DT, const bf16_t* ST, const bf16_t* PROJ, bf16_t* MIX, const float* alog_f, const float* alog_b, const float* dtb_f, const float* dtb_b,
                                           const float* dskip, const float* normw, LAS unsigned char* lds, int vcu, int G, int tid, int wave, int lane) {
    for (int unit = vcu; unit < BATCH * 32 * 2; unit += G) {
        const int g = unit & 1, c = (unit >> 1) & 31, b = unit >> 6;
        const int h2 = lane >> 5, hi = h2, l31 = lane & 31;
        const int hh = wave & 3, lh = wave >> 2, h = 4 * g + hh;
        bf16x8 pf[8][2];
        { const bf16_t* pp = ST + ((((size_t)b * 32 + c) * 2 + 0) * 8 + h) * 8192;
#pragma unroll
          for (int ks = 0; ks < 8; ++ks)
#pragma unroll
              for (int pt = 0; pt < 2; ++pt) pf[ks][pt] = *(const bf16x8*)(pp + (32 * pt + l31) * 128 + 16 * ks + 8 * h2); }
        (void)ssd_stage(XBC2, DT, alog_f, alog_b, dtb_f, dtb_b, b, c, g, true, lds, tid, wave, lane);
        __syncthreads();
        {
            const int lt = wave >> 1; f32x16 cb[2];
#pragma unroll
            for (int q = 0; q < 2; ++q)
#pragma unroll
                for (int rr = 0; rr < 16; ++rr) cb[q][rr] = 0.f;
#pragma unroll 2
            for (int ks = 0; ks < 8; ++ks) { const bf16x8 bf = frag_row(lds + SL_C, SSD_RS, 32 * lt, 16 * ks, lane);
#pragma unroll
                for (int q = 0; q < 2; ++q) { const bf16x8 af = frag_row(lds + SL_B, SSD_RS, 32 * (2 * (wave & 1) + q), 16 * ks, lane); cb[q] = __builtin_amdgcn_mfma_f32_32x32x16_bf16(af, bf, cb[q], 0, 0, 0); } }
            __syncthreads();
#pragma unroll
            for (int q = 0; q < 2; ++q)
#pragma unroll
                for (int rg = 0; rg < 4; ++rg) { u32x2 w; w.x = cvtpk(cb[q][4 * rg], cb[q][4 * rg + 1]); w.y = cvtpk(cb[q][4 * rg + 2], cb[q][4 * rg + 3]);
                    *(LAS u32x2*)(lds + SL_B + (32 * lt + l31) * SSD_RS + (32 * (2 * (wave & 1) + q) + 8 * rg + 4 * hi) * 2) = w; }
            __syncthreads();
        }
        const float Dh = dskip[h];
        f32x16 Yc[2][2];
#pragma unroll
        for (int lt = 0; lt < 2; ++lt)
#pragma unroll
            for (int pt = 0; pt < 2; ++pt)
#pragma unroll
                for (int rr = 0; rr < 16; ++rr) Yc[lt][pt][rr] = 0.f;
#pragma unroll
        for (int dir = 0; dir < 2; ++dir) {
            const LAS float* cs = (const LAS float*)(lds + SL_TAB + (dir * 4 + hh) * 1024); const LAS float* dtv = cs + 128;
            {
                const float el0 = __expf(cs[64 * lh + l31]), el1 = __expf(cs[64 * lh + 32 + l31]);
#pragma unroll
                for (int ks = 0; ks < 8; ++ks) {
#pragma unroll
                    for (int lt = 0; lt < 2; ++lt) { const bf16x8 raw = frag_row(lds + SL_C, SSD_RS, 64 * lh + 32 * lt, 16 * ks, lane); const float el = lt ? el1 : el0;
                        u32x4 w; w.x = cvtpk(bfx(raw[0]) * el, bfx(raw[1]) * el); w.y = cvtpk(bfx(raw[2]) * el, bfx(raw[3]) * el); w.z = cvtpk(bfx(raw[4]) * el, bfx(raw[5]) * el); w.w = cvtpk(bfx(raw[6]) * el, bfx(raw[7]) * el);
                        const bf16x8 af = __builtin_bit_cast(bf16x8, w);
#pragma unroll
                        for (int pt = 0; pt < 2; ++pt) Yc[lt][pt] = __builtin_amdgcn_mfma_f32_32x32x16_bf16(af, pf[ks][pt], Yc[lt][pt], 0, 0, 0); }
                    __builtin_amdgcn_sched_barrier(0); }
            }
            if (dir == 0) {
                const bf16_t* pp = ST + ((((size_t)b * 32 + c) * 2 + 1) * 8 + h) * 8192;
#pragma unroll
                for (int ks = 0; ks < 8; ++ks)
#pragma unroll
                    for (int pt = 0; pt < 2; ++pt) pf[ks][pt] = *(const bf16x8*)(pp + (32 * pt + l31) * 128 + 16 * ks + 8 * h2); }
#pragma unroll 1
            for (int ks = 0; ks < 8; ++ks) {
                const bool need0 = dir ? (16 * ks + 15 >= 64 * lh) : (16 * ks <= 64 * lh + 31), need1 = dir ? (16 * ks + 15 >= 64 * lh + 32) : (16 * ks <= 64 * lh + 63);
                if (!(need0 || need1)) continue;
                bf16x8 xf[2];
#pragma unroll
                for (int pt = 0; pt < 2; ++pt) xf[pt] = frag_tr(lds + SL_X, SSD_RSX, 16 * ks, 64 * hh + 32 * pt, lane);
                const f32x4 c0 = *(const LAS f32x4*)(cs + 16 * ks + 8 * h2), c1 = *(const LAS f32x4*)(cs + 16 * ks + 8 * h2 + 4);
                const f32x4 e0 = *(const LAS f32x4*)(dtv + 16 * ks + 8 * h2), e1 = *(const LAS f32x4*)(dtv + 16 * ks + 8 * h2 + 4);
#pragma unroll
                for (int lt = 0; lt < 2; ++lt) { if (!(lt ? need1 : need0)) continue;
                    const int l = 64 * lh + 32 * lt + l31; const float csl = cs[l];
                    const bf16x8 cbv = frag_row(lds + SL_B, SSD_RS, 64 * lh + 32 * lt, 16 * ks, lane);
                    float gv[8];
#pragma unroll
                    for (int j = 0; j < 8; ++j) { const int sidx = 16 * ks + 8 * h2 + j; const float cj = j < 4 ? c0[j] : c1[j - 4], dj = j < 4 ? e0[j] : e1[j - 4];
                        const bool ok = dir ? (sidx >= l) : (sidx <= l); float gg = ok ? bfx(cbv[j]) * __expf(csl - cj) * dj : 0.f; if (dir == 0 && sidx == l) gg += Dh; gv[j] = gg; }
                    u32x4 w; w.x = cvtpk(gv[0], gv[1]); w.y = cvtpk(gv[2], gv[3]); w.z = cvtpk(gv[4], gv[5]); w.w = cvtpk(gv[6], gv[7]);
                    const bf16x8 af = __builtin_bit_cast(bf16x8, w);
#pragma unroll
                    for (int pt = 0; pt < 2; ++pt) Yc[lt][pt] = __builtin_amdgcn_mfma_f32_32x32x16_bf16(af, xf[pt], Yc[lt][pt], 0, 0, 0); }
            }
        }
        __syncthreads();
        { LAS unsigned char* yimg = lds + (64 * lh) * SSD_RSY + (64 * hh + l31) * 4;
#pragma unroll
          for (int lt = 0; lt < 2; ++lt)
#pragma unroll
              for (int pt = 0; pt < 2; ++pt)
#pragma unroll
                  for (int rr = 0; rr < 16; ++rr) *(LAS float*)(yimg + (32 * lt + crow(rr, hi)) * SSD_RSY + 32 * pt * 4) = Yc[lt][pt][rr]; }
        __syncthreads();
        {
            const f32x4 nw = *(const f32x4*)(normw + 256 * g + 4 * lane);
#pragma unroll 4
            for (int rr = 0; rr < 16; ++rr) { const int l = wave * 16 + rr; const size_t tok = (size_t)b * SEQ + 128 * c + l;
                const f32x4 y = *(const LAS f32x4*)(lds + l * SSD_RSY + 16 * lane);
                const u32x2 zw = *(const u32x2*)(PROJ + tok * PROJW + COL_Z + 256 * g + 4 * lane);
                const f32x4 z = (f32x4){bflo(zw.x), bfhi(zw.x), bflo(zw.y), bfhi(zw.y)};
                f32x4 v;
#pragma unroll
                for (int e = 0; e < 4; ++e) v[e] = y[e] * z[e] * __builtin_amdgcn_rcpf(1.0f + __expf(-z[e]));
                const float ss = wave_sum((v[0] * v[0] + v[1] * v[1]) + (v[2] * v[2] + v[3] * v[3]));
                const float r = 1.0f / sqrtf(ss * (1.0f / 256.0f) + EPS);
                u32x2 o; o.x = cvtpk(v[0] * r * nw[0], v[1] * r * nw[1]); o.y = cvtpk(v[2] * r * nw[2], v[3] * r * nw[3]);
                *(u32x2*)(MIX + tok * 1024 + 512 + 256 * g + 4 * lane) = o; }
        }
        __syncthreads();
    }
}

#define XB_TMO      128
#define XB_XCNT(j)  (256  + 64 * (j))
#define XB_XSUB(j)  (1280 + 64 * (j))
#define XB_XGEN(j)  (2304 + 64 * (j))
#define XB_TOP      3328
#define XB_TOPGEN   3392
#define XCD_BAR_WORDS 3456
#define XB_SPIN_CAP (1u << 18)
__device__ __forceinline__ unsigned xb_ld(unsigned* p)              { return __hip_atomic_load(p, __ATOMIC_RELAXED, __HIP_MEMORY_SCOPE_AGENT); }
__device__ __forceinline__ unsigned xb_add(unsigned* p, unsigned v) { return __hip_atomic_fetch_add(p, v, __ATOMIC_RELAXED, __HIP_MEMORY_SCOPE_AGENT); }
__device__ __forceinline__ unsigned xb_xcc_id() { return (unsigned)__builtin_amdgcn_s_getreg((3 << 11) | 20) & 0xFu; }
#define XB_SPIN(cond, bar) do { unsigned _sp = 0; while (cond) { __builtin_amdgcn_s_sleep(1); \
    if ((++_sp & 255u) == 0u) { if (xb_ld(&(bar)[XB_TMO])) break; if (_sp > XB_SPIN_CAP) { atomicAdd(&(bar)[XB_TMO], 1u); break; } } } } while (0)
struct XcdBarrier { unsigned* bar; unsigned x; volatile LAS unsigned* st; };
__device__ __forceinline__ XcdBarrier xcd_barrier_post(unsigned* bar, volatile LAS unsigned* st) {
    XcdBarrier b; b.bar = bar; b.x = xb_xcc_id(); b.st = st;
    if (threadIdx.x == 0) (void)xb_add(&bar[XB_XCNT(b.x)], 1u);
    return b;
}
__device__ __forceinline__ void xcd_barrier_complete(unsigned* bar, unsigned x, unsigned& nloc, unsigned& nx) {
    const unsigned G = gridDim.x * gridDim.y * gridDim.z;
    unsigned sum, cnt, mine, sp = 0u;
    for (;;) {
        sum = 0u; cnt = 0u; mine = 0u;
#pragma unroll
        for (unsigned j = 0; j < 16; ++j) { const unsigned c = xb_ld(&bar[XB_XCNT(j)]); sum += c; cnt += (c > 0u) ? 1u : 0u; mine = (j == x) ? c : mine; }
        if (sum == G) break;
        __builtin_amdgcn_s_sleep(1);
        if ((++sp & 255u) == 0u) { if (xb_ld(&bar[XB_TMO])) break; if (sp > XB_SPIN_CAP) { atomicAdd(&bar[XB_TMO], 1u); break; } }
    }
    nloc = mine > 0u ? mine : 1u; nx = cnt > 0u ? cnt : 1u;
}
__device__ __forceinline__ void xcd_barrier(const XcdBarrier& b) {
    asm volatile("s_waitcnt vmcnt(0)" ::: "memory");
    __syncthreads();
    if (threadIdx.x == 0) {
        unsigned* bar = b.bar;
        __builtin_amdgcn_s_waitcnt(0);
        unsigned nloc = b.st[0], nx = b.st[1];
        if (nloc == 0u) { xcd_barrier_complete(bar, b.x, nloc, nx); b.st[0] = nloc; b.st[1] = nx; }
        const unsigned old = xb_add(&bar[XB_XSUB(b.x)], 1u);
        const unsigned gen = old / nloc;
        if (old + 1u == (gen + 1u) * nloc) {
            __builtin_amdgcn_fence(__ATOMIC_RELEASE, "agent");
            asm volatile("s_waitcnt vmcnt(0)" ::: "memory");
            const unsigned og = xb_add(&bar[XB_TOP], 1u);
            const unsigned tg = og / nx;
            if (og + 1u == (tg + 1u) * nx) xb_add(&bar[XB_TOPGEN], 1u);
            else XB_SPIN(xb_ld(&bar[XB_TOPGEN]) == tg, bar);
            __builtin_amdgcn_fence(__ATOMIC_ACQUIRE, "agent");
            xb_add(&bar[XB_XGEN(b.x)], 1u);
            asm volatile("s_waitcnt vmcnt(0)" ::: "memory");
        } else {
            XB_SPIN(xb_ld(&bar[XB_XGEN(b.x)]) == gen, bar);
            __builtin_amdgcn_fence(__ATOMIC_ACQUIRE, "agent");
            asm volatile("s_waitcnt vmcnt(0)" ::: "memory");
        }
    }
    __syncthreads();
}

struct Args { const float* in[24]; float* out; unsigned char* ws; int ph_lo, ph_hi; };
enum { I_X = 0, I_W_IN, I_ATTN_NORM_W, I_CONV_W, I_CONV_B, I_DT_BIAS_F, I_A_LOG_F, I_DT_BIAS_B, I_A_LOG_B, I_D_SKIP, I_SSD_NORM_W,
       I_W_OUT, I_LN1_W, I_LN1_B, I_ROUTER_W, I_ROUTER_B, I_W_GATE, I_B_GATE, I_W_UP, I_B_UP, I_W_DOWN, I_B_DOWN, I_LN2_W, I_LN2_B };
#define INP(name) in_ptr(lds, I_##name)

__device__ __forceinline__ void transpose_item(const float* W, int ldw, int k0, int n0, bf16_t* WT, int dbase, int dmul, LAS float* scr, int lane) {
    float v[32];
    const float* wp = W + (size_t)(k0 + (lane >> 5)) * ldw + n0 + (lane & 31);
#pragma unroll
    for (int i = 0; i < 32; ++i) v[i] = wp[(size_t)(2 * i) * ldw];
#pragma unroll
    for (int i = 0; i < 32; ++i) scr[(2 * i + (lane >> 5)) * 33 + (lane & 31)] = v[i];
    LDS_WAIT(); asm volatile("" ::: "memory");
    const int c = lane & 7;
#pragma unroll
    for (int j = 0; j < 4; ++j) { const int n = (lane >> 3) + 8 * j; const LAS float* sp = scr + (8 * c) * 33 + n;
        u32x4 o; o.x = cvtpk(sp[0 * 33], sp[1 * 33]); o.y = cvtpk(sp[2 * 33], sp[3 * 33]); o.z = cvtpk(sp[4 * 33], sp[5 * 33]); o.w = cvtpk(sp[6 * 33], sp[7 * 33]);
        *(u32x4*)(WT + (size_t)(dbase + dmul * n) * 1024 + k0 + 8 * c) = o; }
    LDS_WAIT(); asm volatile("" ::: "memory");
}

__device__ __forceinline__ void transpose_item_f8(const float* W, int ldw, int k0, int n0, unsigned char* WT, int dbase, float sc, LAS float* scr, int lane) {
    float v[32];
    const float* wp = W + (size_t)(k0 + (lane >> 5)) * ldw + n0 + (lane & 31);
#pragma unroll
    for (int i = 0; i < 32; ++i) v[i] = wp[(size_t)(2 * i) * ldw];
#pragma unroll
    for (int i = 0; i < 32; ++i) scr[(2 * i + (lane >> 5)) * 33 + (lane & 31)] = v[i] * sc;
    LDS_WAIT(); asm volatile("" ::: "memory");
    const int c = lane & 7;
#pragma unroll
    for (int j = 0; j < 4; ++j) { const int n = (lane >> 3) + 8 * j; const LAS float* sp = scr + (8 * c) * 33 + n;
        int lo = __builtin_amdgcn_cvt_pk_fp8_f32(sp[0 * 33], sp[1 * 33], 0, false); lo = __builtin_amdgcn_cvt_pk_fp8_f32(sp[2 * 33], sp[3 * 33], lo, true);
        int hi = __builtin_amdgcn_cvt_pk_fp8_f32(sp[4 * 33], sp[5 * 33], 0, false); hi = __builtin_amdgcn_cvt_pk_fp8_f32(sp[6 * 33], sp[7 * 33], hi, true);
        *(u32x2*)(WT + (size_t)(dbase + n) * 1024 + k0 + 8 * c) = (u32x2){(unsigned)lo, (unsigned)hi}; }
    LDS_WAIT(); asm volatile("" ::: "memory");
}

__global__ void __launch_bounds__(NTHREADS, 2) hymba_fwd(Args a) {
    extern __shared__ __attribute__((aligned(16))) unsigned char lds_raw[];
    LAS unsigned char* lds = (LAS unsigned char*)lds_raw;
    const int tid0 = threadIdx.x, wave = __builtin_amdgcn_readfirstlane(tid0 >> 6);
    int tid = tid0; const int lane = tid & 63;
    const int G = gridDim.x; const int bx = blockIdx.x; const int vcu = (G % 8 == 0) ? (bx % 8) * (G / 8) + bx / 8 : bx;
    const int gw = vcu * NWAVES + wave, NGW = G * NWAVES;
    unsigned char* ws = a.ws;
    unsigned* ctl = (unsigned*)(ws + WS_CTL);
    f32x2* rope = (f32x2*)(ws + WS_ROPE);
    bf16_t* WIN = (bf16_t*)(ws + WS_WIN); bf16_t* WOUT = (bf16_t*)(ws + WS_WOUT); bf16_t* WGU = (bf16_t*)(ws + WS_WGU);
    unsigned char* WDN8 = ws + WS_WDN;
    float* TOPG = (float*)(ws + RT_TOPG);
    int* TOKV = (int*)(ws + WS_WIN); int* ROWOF = (int*)(ws + RT_YROW); int* GCNT = (int*)(ws + WS_CTL + 65536);
    float* DT = (float*)(ws + WS_DT);
    unsigned* WQ = (unsigned*)(ws + WS_CTL + 98304);
    bf16_t* XB = (bf16_t*)(ws + WS_XB); bf16_t* MIX = (bf16_t*)a.out;     bf16_t* H1 = (bf16_t*)(ws + WS_H1);
    bf16_t* PROJ = (bf16_t*)(ws + WS_PROJ); bf16_t* XBC2 = (bf16_t*)(ws + WS_XBC2); bf16_t* ATTO = (bf16_t*)(ws + WS_ATTO);
    unsigned char* ACT8 = ws + WS_ACT; unsigned char* Y8 = ws + WS_Y;
    float* ML = (float*)(ws + WS_ML); unsigned char* H1F8 = ws + WS_H1F8; unsigned char* WGU8 = ws + WS_WGU;
    bf16_t* ST = (bf16_t*)((unsigned char*)a.out + 64 * MiB); float* CD = (float*)(ws + RT_CD);
    float* YD = a.out;
    bf16_t* PRE1 = (bf16_t*)((unsigned char*)a.out + 64 * MiB);

    for (int u = tid; u < (LDS_BYTES - LDS_MISC) / 4; u += NTHREADS) ((LAS unsigned*)(lds + LDS_MISC))[u] = 0u;
    if (tid < 24) ((LAS unsigned long long*)(lds + LM_PTRS))[tid] = (unsigned long long)a.in[tid];
    __syncthreads();
    XcdBarrier bar = xcd_barrier_post(ctl + CW_BAR, (volatile LAS unsigned*)(lds + LM_BAR));
#define IN(k) true
#define SEAM(k) do { if (IN(k) && IN((k) + 1)) xcd_barrier(bar); } while (0)
#ifndef RPMASK
#define RPMASK 0
#endif
#define REP(k) for (int _r = 0; _r < ((((RPMASK) >> (k)) & 1) ? 2 : 1); ++_r)

    constexpr int NEI = 3 * NE * 512;
    unsigned* QW = WQ + 192;
    auto expert_item = [&](int r) {
        int ln = threadIdx.x; asm volatile("" : "+v"(ln)); ln &= 63;
        LAS float* scr = (LAS float*)(lds + wave * 16384);
        const int which = r / (NE * 512); r -= which * (NE * 512); const int e = r >> 9, q = r & 511, kb = q >> 5, n0 = 32 * (q & 31);
        if (which == 2) transpose_item_f8(INP(W_DOWN) + (size_t)e * 1024 * 1024, 1024, 64 * kb, n0, WDN8 + (size_t)e * 1024 * 1024, n0, F8_SCALE_D, scr, ln);
        else transpose_item_f8((which ? INP(W_UP) : INP(W_GATE)) + (size_t)e * 1024 * 1024, 1024, 64 * kb, n0, WGU8 + (size_t)e * 2048 * 1024, (n0 >> 7) * 256 + which * 128 + (n0 & 127), F8_SCALE_W, scr, ln);
    };
    auto steal_wait = [&]() {
        volatile LAS int* sw = (volatile LAS int*)(lds + LM_STEAL);
        asm volatile("s_waitcnt vmcnt(0)" ::: "memory");
        __syncthreads();
        unsigned gen = 0u, tg = 0u; int role = 0;
        unsigned* bw = bar.bar;
        if (threadIdx.x == 0) {
            __builtin_amdgcn_s_waitcnt(0);
            unsigned nloc = bar.st[0], nx = bar.st[1];
            if (nloc == 0u) { xcd_barrier_complete(bw, bar.x, nloc, nx); bar.st[0] = nloc; bar.st[1] = nx; }
            const unsigned old = xb_add(&bw[XB_XSUB(bar.x)], 1u);
            gen = old / nloc;
            if (old + 1u == (gen + 1u) * nloc) {
                __builtin_amdgcn_fence(__ATOMIC_RELEASE, "agent");
                asm volatile("s_waitcnt vmcnt(0)" ::: "memory");
                const unsigned og = xb_add(&bw[XB_TOP], 1u);
                tg = og / nx; role = 1;
                if (og + 1u == (tg + 1u) * nx) { xb_add(&bw[XB_TOPGEN], 1u); role = 2; }
            }
        }
        for (unsigned sp = 0u; ; ++sp) {
            if (threadIdx.x == 0) {
                bool open = role == 2 ? true : (role == 1 ? xb_ld(&bw[XB_TOPGEN]) != tg : xb_ld(&bw[XB_XGEN(bar.x)]) != gen);
                if (!open && (sp & 63u) == 63u) { if (xb_ld(&bw[XB_TMO])) open = true; else if (sp > XB_SPIN_CAP) { atomicAdd(&bw[XB_TMO], 1u); open = true; } }
                int base = NEI;
                if (open) { __builtin_amdgcn_fence(__ATOMIC_ACQUIRE, "agent"); if (role != 0) xb_add(&bw[XB_XGEN(bar.x)], 1u); asm volatile("s_waitcnt vmcnt(0)" ::: "memory"); }
                else if (sw[2] == 0) { base = (int)xb_add(QW, 8u); if (base >= NEI) { base = NEI; sw[2] = 1; } }
                sw[0] = open ? 1 : 0; sw[1] = base;
            }
            __syncthreads();
            const int open = sw[0], base = sw[1];
            if (open) break;
            if (base < NEI) expert_item(base + wave); else __builtin_amdgcn_s_sleep(4);
            __syncthreads();
        }
        __syncthreads();
    };
    auto steal_drain = [&]() {
        volatile LAS int* sw = (volatile LAS int*)(lds + LM_STEAL);
        for (;;) { __syncthreads(); if (threadIdx.x == 0) sw[1] = (int)xb_add(QW, 8u); __syncthreads(); const int base = sw[1]; if (base >= NEI) break; expert_item(base + wave); }
        xcd_barrier(bar);
    };

    REP(0) if (IN(0)) {
        int tid = threadIdx.x; asm volatile("" : "+v"(tid)); tid &= 511; const int lane = tid & 63; (void)lane;
        for (int i = gw * 64 + lane; i < SEQ * 32; i += NGW * 64) { const int pos = i >> 5, j = i & 31;
            const float inv = powf(10000.0f, -(float)j / 32.0f); const float ang = (float)pos * inv; float s, c; sincosf(ang, &s, &c); rope[i] = (f32x2){c, s}; }
        LAS float* scr = (LAS float*)(lds + wave * 16384);
        constexpr int I_IN = 16 * 96, I_OUT = 16 * 32;
        constexpr int NITEMS = I_IN + I_OUT;
        for (int it = gw; it < NITEMS; it += NGW) {
            int r = it;
            if (r < I_IN) { const int kb = r / 96, nb = r % 96, n0 = 32 * nb;
                if (n0 < 1024) transpose_item(INP(W_IN), WIN_LD, 64 * kb, n0, WIN, (n0 & ~63) + ((n0 >> 5) & 1), 2, scr, lane);
                else transpose_item(INP(W_IN), WIN_LD, 64 * kb, n0, WIN, n0, 1, scr, lane);
                continue; } r -= I_IN;
            transpose_item(INP(W_OUT), 1024, 64 * (r / 32), 32 * (r % 32), WOUT, 32 * (r % 32), 1, scr, lane);
        }
        __syncthreads();
        LAS float* wdt = (LAS float*)lds;
        { const float* wi = INP(W_IN);
#pragma unroll 1
          for (int b0 = 0; b0 < 32; b0 += 16) { float t[16];
#pragma unroll
              for (int u = 0; u < 16; ++u) { const int i = tid + (b0 + u) * NTHREADS; t[u] = wi[(size_t)(i >> 4) * WIN_LD + 3072 + (i & 15)]; }
#pragma unroll
              for (int u = 0; u < 16; ++u) { const int i = tid + (b0 + u) * NTHREADS; wdt[(i & 15) * 1024 + (i >> 4)] = t[u]; } } }
        __syncthreads();
        {
            const float* X = INP(X);
            f32x4 v[2][4], vn[2][4];
            int row = gw;
#pragma unroll
            for (int q = 0; q < 2; ++q)
#pragma unroll
                for (int j = 0; j < 4; ++j) v[q][j] = ((const f32x4*)(X + (size_t)(row + q * NGW) * DM) + lane)[64 * j];
            for (; row < NTOK; row += 2 * NGW) {
                const int nrow = row + 2 * NGW;
                if (nrow < NTOK) {
#pragma unroll
                    for (int q = 0; q < 2; ++q)
#pragma unroll
                        for (int j = 0; j < 4; ++j) vn[q][j] = ((const f32x4*)(X + (size_t)(nrow + q * NGW) * DM) + lane)[64 * j]; }
#pragma unroll
                for (int q = 0; q < 2; ++q) { u32x2* o8 = (u32x2*)(XB + (size_t)(row + q * NGW) * DM) + lane;
#pragma unroll
                    for (int j = 0; j < 4; ++j) { u32x2 w; w.x = cvtpk(v[q][j][0], v[q][j][1]); w.y = cvtpk(v[q][j][2], v[q][j][3]); o8[64 * j] = w; } }
#pragma unroll 1
                for (int cg = 0; cg < 4; ++cg) {
                    float sacc[8];
#pragma unroll
                    for (int ci = 0; ci < 4; ++ci) { f32x2 s2 = (f32x2){0.f, 0.f};
#pragma unroll
                        for (int j = 0; j < 4; ++j) { const f32x4 w = *(const LAS f32x4*)(wdt + (4 * cg + ci) * 1024 + 256 * j + 4 * lane);
#pragma unroll
                            for (int e = 0; e < 4; ++e) s2 = __builtin_elementwise_fma((f32x2){v[0][j][e], v[1][j][e]}, (f32x2){w[e], w[e]}, s2); }
                        sacc[ci] = s2[0]; sacc[4 + ci] = s2[1]; }
                    bfly_reduce<8>(sacc, lane);
                    if ((lane & 7) == 0) DT[(size_t)(row + (lane >> 5) * NGW) * 16 + 4 * cg + ((lane >> 3) & 3)] = sacc[0];
                }
#pragma unroll
                for (int q = 0; q < 2; ++q)
#pragma unroll
                    for (int j = 0; j < 4; ++j) v[q][j] = vn[q][j];
            }
        }
    }
    SEAM(0);

    REP(1) if (IN(1)) {
        int tid = threadIdx.x; asm volatile("" : "+v"(tid)); tid &= 511; const int lane = tid & 63; (void)lane;
        pg8::StaticOrder S; S.init(NTOK, PROJW, G, bx, WIN); pg8::IdentityRows RM; pg8::EpiProj E{PROJ, rope};
        pg8::gemm_phase(lds, XB, S, RM, E);
    }
    steal_wait();

    REP(2) if (IN(2)) {
        int tid = threadIdx.x; asm volatile("" : "+v"(tid)); tid &= 511; const int lane = tid & 63; (void)lane;
        REP(14) {
            const float* cwp = INP(CONV_W); const float* cbp = INP(CONV_B);
            for (int item = gw; item < (NTOK / 16) * 2; item += NGW) {
                const int half = item & 1, run = item >> 1, c8 = half * 512 + lane * 8, tok0 = run * 16, pos0 = tok0 & (SEQ - 1);
                f32x4 wv[5][2], bv[2];
#pragma unroll
                for (int j = 0; j < 5; ++j) { wv[j][0] = *(const f32x4*)(cwp + j * 1024 + c8); wv[j][1] = *(const f32x4*)(cwp + j * 1024 + c8 + 4); }
                bv[0] = *(const f32x4*)(cbp + c8); bv[1] = *(const f32x4*)(cbp + c8 + 4);
                u32x4 rows[20];
#pragma unroll
                for (int t = 0; t < 20; ++t) { const int p = pos0 + t - 2;
                    rows[t] = (p >= 0 && p < SEQ) ? *(const u32x4*)(PROJ + (size_t)(tok0 + t - 2) * PROJW + COL_X + c8) : (u32x4){0u, 0u, 0u, 0u}; }
#pragma unroll
                for (int t = 0; t < 16; ++t) { f32x4 a0 = bv[0], a1 = bv[1];
#pragma unroll
                    for (int j = 0; j < 5; ++j) { const u32x4 w = rows[t + j];
                        a0 += (f32x4){bflo(w.x), bfhi(w.x), bflo(w.y), bfhi(w.y)} * wv[j][0]; a1 += (f32x4){bflo(w.z), bfhi(w.z), bflo(w.w), bfhi(w.w)} * wv[j][1]; }
#pragma unroll
                    for (int e = 0; e < 4; ++e) { a0[e] = a0[e] * __builtin_amdgcn_rcpf(1.0f + __expf(-a0[e])); a1[e] = a1[e] * __builtin_amdgcn_rcpf(1.0f + __expf(-a1[e])); }
                    u32x4 o; o.x = cvtpk(a0[0], a0[1]); o.y = cvtpk(a0[2], a0[3]); o.z = cvtpk(a1[0], a1[1]); o.w = cvtpk(a1[2], a1[3]);
                    *(u32x4*)(XBC2 + (size_t)(tok0 + t) * 1024 + c8) = o; __builtin_amdgcn_sched_barrier(0); }
            }
        }
        REP(13) attn_pass<1, true>(PROJ, ATTO, ML, lds, vcu, G, wave, lane);
    }
    steal_wait();

    if (IN(3)) {
        int tid = threadIdx.x; asm volatile("" : "+v"(tid)); tid &= 511; const int lane = tid & 63; (void)lane;
        REP(3) ssd_pass_a(XBC2, DT, ST, CD, INP(A_LOG_F), INP(A_LOG_B), INP(DT_BIAS_F), INP(DT_BIAS_B), lds, vcu, G, tid, wave, lane);
        attn_pass<4, false>(PROJ, ATTO, ML, lds, vcu, G, wave, lane);
    }
    steal_wait();

    if (IN(4)) {
        int tid = threadIdx.x; asm volatile("" : "+v"(tid)); tid &= 511; const int lane = tid & 63; (void)lane; ssd_pass_b(ST, CD, gw * 64 + lane, NGW * 64); attn_pass<16, false>(PROJ, ATTO, ML, lds, vcu, G, wave, lane); }
    steal_wait();

    REP(5) if (IN(5)) { int tid = threadIdx.x; asm volatile("" : "+v"(tid)); tid &= 511; const int lane = tid & 63;
        ssd_pass_c(XBC2, DT, ST, PROJ, MIX, INP(A_LOG_F), INP(A_LOG_B), INP(DT_BIAS_F), INP(DT_BIAS_B), INP(D_SKIP), INP(SSD_NORM_W), lds, vcu, G, tid, wave, lane);
        const float* nwp = INP(ATTN_NORM_W) + 8 * lane; const f32x4 nw0 = *(const f32x4*)nwp, nw1 = *(const f32x4*)(nwp + 4);
        for (int tok0 = gw; tok0 < NTOK; tok0 += 4 * NGW) {
            u32x4 wv[4];
#pragma unroll
            for (int q = 0; q < 4; ++q) { const int tok = tok0 + q * NGW; wv[q] = tok < NTOK ? *(const u32x4*)(ATTO + (size_t)tok * 512 + 8 * lane) : (u32x4){0u, 0u, 0u, 0u}; }
#pragma unroll
            for (int q = 0; q < 4; ++q) { const int tok = tok0 + q * NGW; const u32x4 w = wv[q];
                float v[8] = {bflo(w.x), bfhi(w.x), bflo(w.y), bfhi(w.y), bflo(w.z), bfhi(w.z), bflo(w.w), bfhi(w.w)};
                float ss = 0.f;
#pragma unroll
                for (int e = 0; e < 8; ++e) ss += v[e] * v[e];
                ss = wave_sum(ss); const float r = 1.0f / sqrtf(ss * (1.0f / 512.0f) + EPS);
                u32x4 o; o.x = cvtpk(v[0] * r * nw0[0], v[1] * r * nw0[1]); o.y = cvtpk(v[2] * r * nw0[2], v[3] * r * nw0[3]); o.z = cvtpk(v[4] * r * nw1[0], v[5] * r * nw1[1]); o.w = cvtpk(v[6] * r * nw1[2], v[7] * r * nw1[3]);
                if (tok < NTOK) *(u32x4*)(MIX + (size_t)tok * 1024 + 8 * lane) = o; }
        }
    }
    steal_wait();

    REP(7) if (IN(7)) {
        int tid = threadIdx.x; asm volatile("" : "+v"(tid)); tid &= 511; const int lane = tid & 63; (void)lane;
        pg8::StaticOrder S; S.init(NTOK, DM, G, bx, WOUT); pg8::IdentityRows RM; pg8::EpiOut E{XB, PRE1};
        pg8::gemm_phase(lds, MIX, S, RM, E);
    }
    steal_wait();

    REP(8) if (IN(8)) {
        int tid = threadIdx.x; asm volatile("" : "+v"(tid)); tid &= 511; const int lane = tid & 63; (void)lane;
        LAS float* rwT = (LAS float*)lds;
        { const float* rw = INP(ROUTER_W);
#pragma unroll 1
          for (int b0 = 0; b0 < 64; b0 += 16) { float t[16];
#pragma unroll
              for (int u = 0; u < 16; ++u) t[u] = rw[tid + (b0 + u) * NTHREADS];
#pragma unroll
              for (int u = 0; u < 16; ++u) { const int i = tid + (b0 + u) * NTHREADS; rwT[(i & 31) * 1028 + (i >> 5)] = t[u]; } } }
        LAS int* hist = (LAS int*)(lds + LM_HIST); LAS int* base = (LAS int*)(lds + LM_BASE); LAS int* pick = (LAS int*)(lds + LM_PICK);
        LAS float* lgs = (LAS float*)(lds + 131584) + wave * 128;
        f32x4 lw[4], lb[4];
#pragma unroll
        for (int j = 0; j < 4; ++j) { lw[j] = ((const f32x4*)INP(LN1_W))[64 * j + lane]; lb[j] = ((const f32x4*)INP(LN1_B))[64 * j + lane]; }
        const float rbias0 = INP(ROUTER_B)[lane & 15], rbias1 = INP(ROUTER_B)[16 + (lane & 15)];
        for (int vb = bx; vb < 256; vb += G) {
            if (tid < 32) hist[tid] = 0;
            __syncthreads();
            const int tokw = vb * 128 + wave * 16;
            f32x4 v[4][4]; u32x2 vn[4][4];
#pragma unroll
            for (int q = 0; q < 4; ++q)
#pragma unroll
                for (int j = 0; j < 4; ++j) { const u32x2 w = ((const u32x2*)(PRE1 + (size_t)(tokw + q) * DM) + lane)[64 * j]; v[q][j] = (f32x4){bflo(w.x), bfhi(w.x), bflo(w.y), bfhi(w.y)}; }
#pragma unroll 1
            for (int qi = 0; qi < 4; ++qi) {
                const int tok0 = tokw + 4 * qi;
                if (qi < 3) {
#pragma unroll
                    for (int q = 0; q < 4; ++q)
#pragma unroll
                        for (int j = 0; j < 4; ++j) vn[q][j] = ((const u32x2*)(PRE1 + (size_t)(tok0 + 4 + q) * DM) + lane)[64 * j]; }
#pragma unroll
                for (int q = 0; q < 4; ++q) { float s = 0.f;
#pragma unroll
                    for (int j = 0; j < 4; ++j) s += (v[q][j][0] + v[q][j][1]) + (v[q][j][2] + v[q][j][3]);
                    const float mean = wave_sum(s) * (1.0f / DM); float s2 = 0.f;
#pragma unroll
                    for (int j = 0; j < 4; ++j) { v[q][j] = v[q][j] - mean; s2 += (v[q][j][0] * v[q][j][0] + v[q][j][1] * v[q][j][1]) + (v[q][j][2] * v[q][j][2] + v[q][j][3] * v[q][j][3]); }
                    const float rstd = 1.0f / sqrtf(wave_sum(s2) * (1.0f / DM) + EPS);
                    u32x2* o8 = (u32x2*)(H1 + (size_t)(tok0 + q) * DM) + lane;
#pragma unroll
                    for (int j = 0; j < 4; ++j) { v[q][j] = v[q][j] * rstd * lw[j] + lb[j]; u32x2 w; w.x = cvtpk(v[q][j][0], v[q][j][1]); w.y = cvtpk(v[q][j][2], v[q][j][3]); o8[64 * j] = w;
                        int p8 = __builtin_amdgcn_cvt_pk_fp8_f32(v[q][j][0] * F8_SCALE_H, v[q][j][1] * F8_SCALE_H, 0, false); p8 = __builtin_amdgcn_cvt_pk_fp8_f32(v[q][j][2] * F8_SCALE_H, v[q][j][3] * F8_SCALE_H, p8, true);
                        ((int*)(H1F8 + (size_t)(tok0 + q) * DM))[64 * j + lane] = p8; } }
                f32x2 hp[2][4][4];
#pragma unroll
                for (int j = 0; j < 4; ++j)
#pragma unroll
                    for (int e = 0; e < 4; ++e) { hp[0][j][e] = (f32x2){v[0][j][e], v[1][j][e]}; hp[1][j][e] = (f32x2){v[2][j][e], v[3][j][e]}; }
#pragma unroll 1
                for (int eg = 0; eg < 8; ++eg) {
                    float sacc[16];
#pragma unroll
                    for (int ei = 0; ei < 4; ++ei) { f32x2 sa = (f32x2){0.f, 0.f}, sb = (f32x2){0.f, 0.f};
#pragma unroll
                        for (int j = 0; j < 4; ++j) { const f32x4 w = *(const LAS f32x4*)(rwT + (4 * eg + ei) * 1028 + 256 * j + 4 * lane);
#pragma unroll
                            for (int e = 0; e < 4; ++e) { const f32x2 ww = (f32x2){w[e], w[e]}; sa = __builtin_elementwise_fma(hp[0][j][e], ww, sa); sb = __builtin_elementwise_fma(hp[1][j][e], ww, sb); } }
                        sacc[ei] = sa[0]; sacc[4 + ei] = sa[1]; sacc[8 + ei] = sb[0]; sacc[12 + ei] = sb[1]; }
                    bfly_reduce<16>(sacc, lane);
                    if ((lane & 3) == 0) lgs[(lane >> 4) * 32 + 4 * eg + ((lane >> 2) & 3)] = sacc[0];
                }
                const int e0 = lane & 15;
                float l0 = lgs[(lane >> 4) * 32 + e0] + rbias0, l1 = lgs[(lane >> 4) * 32 + 16 + e0] + rbias1;
                int sel[4]; float sv[4];
#pragma unroll
                for (int r = 0; r < 4; ++r) { float bv = l0; int bi = e0; if (l1 > l0) { bv = l1; bi = 16 + e0; }
#define TOPK_STEP(M) { const float ov = lane_xor_f<M>(bv, lane); const int oi = lane_xor_i<M>(bi, lane); if (ov > bv || (ov == bv && oi < bi)) { bv = ov; bi = oi; } }
                    TOPK_STEP(1) TOPK_STEP(2) TOPK_STEP(4) TOPK_STEP(8)
#undef TOPK_STEP
                    sel[r] = bi; sv[r] = bv; if (bi == e0) l0 = -INFINITY; if (bi == 16 + e0) l1 = -INFINITY; }
                const float e1 = __expf(sv[1] - sv[0]), e2 = __expf(sv[2] - sv[0]), e3 = __expf(sv[3] - sv[0]); const float inv = 1.0f / (1.0f + e1 + e2 + e3);
                if ((lane & 15) == 0) { const int tok = tok0 + (lane >> 4);
                    *(f32x4*)(TOPG + (size_t)tok * 4) = (f32x4){inv, e1 * inv, e2 * inv, e3 * inv};
#pragma unroll
                    for (int r = 0; r < 4; ++r) { const int rank = __hip_atomic_fetch_add(hist + sel[r], 1, __ATOMIC_RELAXED, __HIP_MEMORY_SCOPE_WORKGROUP); pick[(tok - vb * 128) * 4 + r] = sel[r] | (rank << 8); } }
#pragma unroll
                for (int q = 0; q < 4; ++q)
#pragma unroll
                    for (int j = 0; j < 4; ++j) { const u32x2 w = vn[q][j]; v[q][j] = (f32x4){bflo(w.x), bfhi(w.x), bflo(w.y), bfhi(w.y)}; }
            }
            __syncthreads();
            if (tid < 32) base[tid] = __hip_atomic_fetch_add(GCNT + tid, hist[tid], __ATOMIC_RELAXED, __HIP_MEMORY_SCOPE_AGENT);
            __syncthreads();
            { const int p = pick[tid], e = p & 255, slot = base[e] + (p >> 8), tok = vb * 128 + (tid >> 2);
              TOKV[e * NTOK + slot] = tok; ROWOF[tok * 4 + (tid & 3)] = (e << 20) | slot; }
            __syncthreads();
        }
    }
    steal_drain();


    REP(10) if (IN(10)) {
        int tid = threadIdx.x; asm volatile("" : "+v"(tid)); tid &= 511; const int lane = tid & 63; (void)lane;
        LAS int* segt = (LAS int*)(lds + LM_SEGT); LAS int* segc = (LAS int*)(lds + LM_SEGC);
        if (tid < 64) { const int c = tid < 32 ? __hip_atomic_load(GCNT + (tid & 31), __ATOMIC_RELAXED, __HIP_MEMORY_SCOPE_AGENT) : 0; int t = (c + 255) >> 8;
#pragma unroll
            for (int d = 1; d < 32; d <<= 1) { const int o = __shfl_up(t, d, 64); if ((tid & 63) >= d) t += o; }
            if (tid < 32) { segc[tid] = c; segt[tid + 1] = t; } if (tid == 0) segt[0] = 0; }
        __syncthreads();
        pg8::GroupedOrder S{0, segt[32], 8, G, vcu, 0, segt, segc, (const char*)WGU8, (size_t)2048 * 1024, 1024, 0};
        pg8::TableRows RM{TOKV}; pg8::EpiAct E{ACT8, INP(B_GATE), INP(B_UP), 1.0f / (F8_SCALE_H * F8_SCALE_W)};
        pg8::gemm_phase<true>(lds, H1F8, S, RM, E);
    }
    SEAM(10);

    REP(11) if (IN(11)) {
        int tid = threadIdx.x; asm volatile("" : "+v"(tid)); tid &= 511; const int lane = tid & 63; (void)lane;
        LAS int* segt = (LAS int*)(lds + LM_SEGT); LAS int* segc = (LAS int*)(lds + LM_SEGC);
        if (tid < 64) { const int c = tid < 32 ? __hip_atomic_load(GCNT + (tid & 31), __ATOMIC_RELAXED, __HIP_MEMORY_SCOPE_AGENT) : 0; int t = (c + 255) >> 8;
#pragma unroll
            for (int d = 1; d < 32; d <<= 1) { const int o = __shfl_up(t, d, 64); if ((tid & 63) >= d) t += o; }
            if (tid < 32) { segc[tid] = c; segt[tid + 1] = t; } if (tid == 0) segt[0] = 0; }
        __syncthreads();
        pg8::GroupedOrder S{0, segt[32], 4, G, vcu, 0, segt, segc, (const char*)WDN8, (size_t)1024 * 1024, 1024, 0};
        pg8::IdentityRows RM; pg8::EpiY E{Y8, INP(B_DOWN), 1.0f / (F8_SCALE_A * F8_SCALE_D)};
        pg8::gemm_phase<true>(lds, ACT8, S, RM, E);
    }
    SEAM(11);

    REP(12) if (IN(12)) {
        int tid = threadIdx.x; asm volatile("" : "+v"(tid)); tid &= 511; const int lane = tid & 63; (void)lane;
        LAS int* segt = (LAS int*)(lds + LM_SEGT); LAS int* segc = (LAS int*)(lds + LM_SEGC);
        if (tid < 64) { const int c = tid < 32 ? __hip_atomic_load(GCNT + (tid & 31), __ATOMIC_RELAXED, __HIP_MEMORY_SCOPE_AGENT) : 0; int t = (c + 255) >> 8;
#pragma unroll
            for (int d = 1; d < 32; d <<= 1) { const int o = __shfl_up(t, d, 64); if ((tid & 63) >= d) t += o; }
            if (tid < 32) { segc[tid] = c; segt[tid + 1] = t; } if (tid == 0) segt[0] = 0; }
        __syncthreads();
        f32x4 lw[4], lb[4];
#pragma unroll
        for (int j = 0; j < 4; ++j) { lw[j] = ((const f32x4*)INP(LN2_W))[64 * j + lane]; lb[j] = ((const f32x4*)INP(LN2_B))[64 * j + lane]; }
#define YROW(w) (segt[(w) >> 20] * 256 + ((w) & 0xFFFFF))
        int tok = gw; int4 rws = make_int4(0, 0, 0, 0); f32x4 gts = (f32x4){0.f, 0.f, 0.f, 0.f};
        if (tok < NTOK) { rws = *(const int4*)(ROWOF + (size_t)tok * 4); gts = *(const f32x4*)(TOPG + (size_t)tok * 4); }
        u32x2 hw[4]; unsigned yw[4][4];
        if (tok < NTOK) { const u32x2* hp = (const u32x2*)(H1 + (size_t)tok * DM) + lane; const int rwa[4] = {YROW(rws.x), YROW(rws.y), YROW(rws.z), YROW(rws.w)};
#pragma unroll
            for (int j = 0; j < 4; ++j) hw[j] = hp[64 * j];
#pragma unroll
            for (int k = 0; k < 4; ++k) { const unsigned* yp = (const unsigned*)(Y8 + (size_t)rwa[k] * 1024) + lane;
#pragma unroll
                for (int j = 0; j < 4; ++j) yw[k][j] = yp[64 * j]; } }
        for (; tok < NTOK; tok += NGW) {
            const int ntok = tok + NGW; int4 nrws = rws; f32x4 ngts = gts;
            if (ntok < NTOK) { nrws = *(const int4*)(ROWOF + (size_t)ntok * 4); ngts = *(const f32x4*)(TOPG + (size_t)ntok * 4); }
            f32x4 v[4];
#pragma unroll
            for (int j = 0; j < 4; ++j) v[j] = (f32x4){bflo(hw[j].x), bfhi(hw[j].x), bflo(hw[j].y), bfhi(hw[j].y)} * ALPHA;
#pragma unroll
            for (int k = 0; k < 4; ++k) { const float gk = gts[k] * (1.0f / F8_SCALE_Y);
#pragma unroll
                for (int j = 0; j < 4; ++j) { const unsigned w = yw[k][j]; const f32x2 lo2 = __builtin_amdgcn_cvt_pk_f32_fp8(w, false), hi2 = __builtin_amdgcn_cvt_pk_f32_fp8(w, true);
                    v[j] = v[j] + (f32x4){lo2[0], lo2[1], hi2[0], hi2[1]} * gk; } }
            if (ntok < NTOK) { const u32x2* hp = (const u32x2*)(H1 + (size_t)ntok * DM) + lane; const int rwa[4] = {YROW(nrws.x), YROW(nrws.y), YROW(nrws.z), YROW(nrws.w)};
#pragma unroll
                for (int j = 0; j < 4; ++j) hw[j] = hp[64 * j];
#pragma unroll
                for (int k = 0; k < 4; ++k) { const unsigned* yp = (const unsigned*)(Y8 + (size_t)rwa[k] * 1024) + lane;
#pragma unroll
                    for (int j = 0; j < 4; ++j) yw[k][j] = yp[64 * j]; } }
            float sm = 0.f;
#pragma unroll
            for (int j = 0; j < 4; ++j) sm += (v[j][0] + v[j][1]) + (v[j][2] + v[j][3]);
            const float mean = wave_sum(sm) * (1.0f / DM); float s2 = 0.f;
#pragma unroll
            for (int j = 0; j < 4; ++j) { v[j] = v[j] - mean; s2 += (v[j][0] * v[j][0] + v[j][1] * v[j][1]) + (v[j][2] * v[j][2] + v[j][3] * v[j][3]); }
            const float rstd = 1.0f / sqrtf(wave_sum(s2) * (1.0f / DM) + EPS);
            f32x4* op = (f32x4*)(a.out + (size_t)tok * DM) + lane;
#pragma unroll
            for (int j = 0; j < 4; ++j) op[64 * j] = v[j] * rstd * lw[j] + lb[j];
            rws = nrws; gts = ngts;
        }
    }
#undef IN
#undef SEAM
}

constexpr int N_PHASES = 13;
extern "C" void kernel_launch(void* const* d_in, const int* in_sizes, int n_in, void* d_out, int out_size, void* d_ws, size_t ws_size, hipStream_t stream) {
    static int grid = 0;
    if (grid == 0) {
        if (n_in != 24 || out_size != NTOK * DM || ws_size < WS_END) { fprintf(stderr, "kernel_launch: unexpected shapes (n_in %d out %d ws %zu)\n", n_in, out_size, ws_size); grid = -1; return; }
        int dev = 0, cus = 0, per_cu = 0;
        if (hipGetDevice(&dev) != hipSuccess || hipDeviceGetAttribute(&cus, hipDeviceAttributeMultiprocessorCount, dev) != hipSuccess) { grid = -1; return; }
        if (hipFuncSetAttribute((const void*)hymba_fwd, hipFuncAttributeMaxDynamicSharedMemorySize, LDS_BYTES) != hipSuccess) { fprintf(stderr, "kernel_launch: hipFuncSetAttribute failed\n"); grid = -1; return; }
        if (hipOccupancyMaxActiveBlocksPerMultiprocessor(&per_cu, (const void*)hymba_fwd, NTHREADS, LDS_BYTES) != hipSuccess || per_cu < 1) { fprintf(stderr, "kernel_launch: occupancy query says %d\n", per_cu); }
        (void)hipGetLastError();
        grid = cus;
    }
    if (grid < 0) return;
    (void)hipMemsetAsync((char*)d_ws + WS_CTL, 0, CTL_ZERO_BYTES, stream);
    Args a{};
    for (int i = 0; i < 24; ++i) a.in[i] = (const float*)d_in[i];
    a.out = (float*)d_out; a.ws = (unsigned char*)d_ws; a.ph_lo = 0; a.ph_hi = N_PHASES;
    hipLaunchKernelGGL(hymba_fwd, dim3(grid), dim3(NTHREADS), LDS_BYTES, stream, a);
}
```

```cpp
#include <hip/hip_runtime.h>
#include <cstdio>
#include <cstdint>
#include <cmath>

#define LAS __attribute__((address_space(3)))
#define GAS __attribute__((address_space(1)))
typedef unsigned short bf16_t;
typedef short bf16x8 __attribute__((ext_vector_type(8)));
typedef float f32x4 __attribute__((ext_vector_type(4)));
typedef float f32x2 __attribute__((ext_vector_type(2)));
typedef unsigned u32x4 __attribute__((ext_vector_type(4)));
typedef unsigned u32x2 __attribute__((ext_vector_type(2)));

constexpr int BATCH = 8, SEQ = 4096, DM = 1024, NTOK = BATCH * SEQ;
constexpr int NH = 8, HD = 64;
constexpr int PROJW = 3072;
constexpr int COL_Q = 0, COL_K = 512, COL_V = 1024, COL_Z = 1536, COL_X = 2048;
constexpr int WIN_LD = 3088;
constexpr int NE = 32, TOPK = 4;
constexpr int MAXROWS = 139264;
constexpr float ALPHA = 1.18920711500272f;
constexpr float EPS = 1e-5f;
constexpr float F8_SCALE_H = 4.0f, F8_SCALE_W = 64.0f, F8_SCALE_A = 4.0f, F8_SCALE_D = 128.0f, F8_SCALE_Y = 16.0f;
constexpr int NWAVES = 8, NTHREADS = 512;

constexpr size_t MiB = 1u << 20;
constexpr size_t WS_CTL = 0, CTL_ZERO_BYTES = 1 * MiB;
constexpr size_t WS_ROPE = 1 * MiB;
constexpr size_t WS_WIN = 2 * MiB;
constexpr size_t WS_WOUT = 8 * MiB;
constexpr size_t WS_ROUTE = 10 * MiB;
constexpr size_t RT_TOPI = WS_ROUTE, RT_TOPG = WS_ROUTE + 512 * 1024, RT_BCNT = WS_ROUTE + 1024 * 1024, RT_SEGT = WS_ROUTE + 1056 * 1024;
constexpr size_t RT_TOKR = WS_ROUTE + 1088 * 1024, RT_GATR = RT_TOKR + 576 * 1024, RT_YROW = RT_GATR + 576 * 1024;
constexpr size_t RT_CD = WS_ROUTE + 4096 * 1024;
constexpr size_t WS_DT = 16 * MiB;
constexpr size_t WS_WGU = 18 * MiB;
constexpr size_t WS_XB = 82 * MiB;
constexpr size_t WS_H1F8 = 82 * MiB;
constexpr size_t WS_PROJ = 146 * MiB;
constexpr size_t WS_H1 = 290 * MiB;
constexpr size_t WS_XBC2 = 338 * MiB;
constexpr size_t WS_ATTO = 402 * MiB;
constexpr size_t WS_ML = 434 * MiB;
constexpr size_t WS_ACT = 354 * MiB;
constexpr size_t WS_Y = 18 * MiB;
constexpr size_t WS_WDN = 490 * MiB;
constexpr size_t WS_END = 522 * MiB;
static_assert(WS_Y + (size_t)MAXROWS * 2048 <= WS_H1 && WS_ACT + (size_t)MAXROWS * 1024 <= WS_WDN && WS_H1 + (size_t)NTOK * 2048 <= WS_ACT, "workspace map");
constexpr int CW_BAR = 4096;

constexpr int RING_BYTES = 131072;
constexpr int LDS_MISC = 155648;
constexpr int LDS_BYTES = 163840;
constexpr int LM_BAR = LDS_MISC + 0;
constexpr int LM_STEAL = LDS_MISC + 64;
constexpr int LM_HIST = LDS_MISC + 256;
constexpr int LM_SEGT = LDS_MISC + 512;
constexpr int LM_SEGC = LDS_MISC + 1024;
constexpr int LM_BASE = LDS_MISC + 1536;
constexpr int LM_PICK = LDS_MISC + 2048;
constexpr int LM_PTRS = LDS_MISC + 4096;
static_assert(LM_PTRS == 155648 + 4096 && LM_PTRS + 192 <= LDS_BYTES, "in_ptr() hard-codes this offset");

__device__ __forceinline__ unsigned f2bf(float f) { unsigned u = __float_as_uint(f); return (u + 0x7fffu + ((u >> 16) & 1u)) >> 16; }
__device__ __forceinline__ unsigned pk2(float lo, float hi) { return f2bf(lo) | (f2bf(hi) << 16); }
__device__ __forceinline__ float bflo(unsigned w) { return __uint_as_float(w << 16); }
__device__ __forceinline__ float bfhi(unsigned w) { return __uint_as_float(w & 0xffff0000u); }
__device__ __forceinline__ float bf2f(bf16_t b) { return __uint_as_float((unsigned)b << 16); }
__device__ __forceinline__ unsigned cvt_pk_bf16(float lo, float hi) { unsigned r; asm volatile("v_cvt_pk_bf16_f32 %0, %1, %2" : "=v"(r) : "v"(lo), "v"(hi)); return r; }
typedef __bf16 bf16x2_t __attribute__((ext_vector_type(2)));
__device__ __forceinline__ unsigned cvtpk(float lo, float hi) { f32x2 v = {lo, hi}; bf16x2_t b = __builtin_convertvector(v, bf16x2_t); return __builtin_bit_cast(unsigned, b); }
template <int M> __device__ __forceinline__ int lane_xor_i(int iv, int lane) {
    if constexpr (M == 1) return __builtin_amdgcn_update_dpp(0, iv, 0xB1, 0xF, 0xF, false);
    else if constexpr (M == 2) return __builtin_amdgcn_update_dpp(0, iv, 0x4E, 0xF, 0xF, false);
    else if constexpr (M == 4) { int t = __builtin_amdgcn_update_dpp(0, iv, 0x104, 0xF, 0x5, false); return __builtin_amdgcn_update_dpp(t, iv, 0x114, 0xF, 0xA, false); }
    else if constexpr (M == 8) return __builtin_amdgcn_update_dpp(0, iv, 0x128, 0xF, 0xF, false);
    else if constexpr (M == 16) { auto rr = __builtin_amdgcn_permlane16_swap((unsigned)iv, (unsigned)iv, false, false); return (int)((lane & 16) ? rr[0] : rr[1]); }
    else { auto rr = __builtin_amdgcn_permlane32_swap((unsigned)iv, (unsigned)iv, false, false); return (int)((lane & 32) ? rr[0] : rr[1]); }
}
template <int M> __device__ __forceinline__ float lane_xor_f(float v, int lane) { return __builtin_bit_cast(float, lane_xor_i<M>(__builtin_bit_cast(int, v), lane)); }
__device__ __forceinline__ float wave_sum(float v) {
    v += lane_xor_f<1>(v, 0); v += lane_xor_f<2>(v, 0); v += lane_xor_f<4>(v, 0); v += lane_xor_f<8>(v, 0);
    { auto rr = __builtin_amdgcn_permlane16_swap(__float_as_uint(v), __float_as_uint(v), false, false); v = __uint_as_float(rr[0]) + __uint_as_float(rr[1]); }
    { auto rr = __builtin_amdgcn_permlane32_swap(__float_as_uint(v), __float_as_uint(v), false, false); v = __uint_as_float(rr[0]) + __uint_as_float(rr[1]); }
    return v;
}
__device__ __forceinline__ float half_sum(float v) {
    v += lane_xor_f<1>(v, 0); v += lane_xor_f<2>(v, 0); v += lane_xor_f<4>(v, 0); v += lane_xor_f<8>(v, 0);
    { auto rr = __builtin_amdgcn_permlane16_swap(__float_as_uint(v), __float_as_uint(v), false, false); v = __uint_as_float(rr[0]) + __uint_as_float(rr[1]); }
    return v;
}
template <int M, int NH>
__device__ __forceinline__ void bfly_step(float* v, int lane) {
#pragma unroll
    for (int i = 0; i < NH; ++i) {
        if constexpr (M == 32) { auto rr = __builtin_amdgcn_permlane32_swap(__float_as_uint(v[i]), __float_as_uint(v[NH + i]), false, false); v[i] = __uint_as_float(rr[0]) + __uint_as_float(rr[1]); }
        else if constexpr (M == 16) { auto rr = __builtin_amdgcn_permlane16_swap(__float_as_uint(v[i]), __float_as_uint(v[NH + i]), false, false); v[i] = __uint_as_float(rr[0]) + __uint_as_float(rr[1]); }
        else { const float lo = v[i] + lane_xor_f<M>(v[i], lane), hi = v[NH + i] + lane_xor_f<M>(v[NH + i], lane); v[i] = (lane & M) ? hi : lo; }
    }
}
template <int N>
__device__ __forceinline__ void bfly_reduce(float (&v)[N], int lane) {
    static_assert(N == 8 || N == 16 || N == 32 || N == 64, "bfly_reduce sizes");
    if constexpr (N == 64) { bfly_step<32, 32>(v, lane); bfly_step<16, 16>(v, lane); bfly_step<8, 8>(v, lane); bfly_step<4, 4>(v, lane); bfly_step<2, 2>(v, lane); bfly_step<1, 1>(v, lane); }
    if constexpr (N == 32) { bfly_step<32, 16>(v, lane); bfly_step<16, 8>(v, lane); bfly_step<8, 4>(v, lane); bfly_step<4, 2>(v, lane); bfly_step<2, 1>(v, lane); v[0] += lane_xor_f<1>(v[0], lane); }
    if constexpr (N == 16) { bfly_step<32, 8>(v, lane); bfly_step<16, 4>(v, lane); bfly_step<8, 2>(v, lane); bfly_step<4, 1>(v, lane); v[0] += lane_xor_f<2>(v[0], lane); v[0] += lane_xor_f<1>(v[0], lane); }
    if constexpr (N == 8) { bfly_step<32, 4>(v, lane); bfly_step<16, 2>(v, lane); bfly_step<8, 1>(v, lane); v[0] += lane_xor_f<4>(v[0], lane); v[0] += lane_xor_f<2>(v[0], lane); v[0] += lane_xor_f<1>(v[0], lane); }
}
#define LDS_WAIT() asm volatile("s_waitcnt lgkmcnt(0)" ::: "memory")
__device__ __forceinline__ const float* in_ptr(LAS unsigned char* lds, int idx) {
    const unsigned long long v = ((const LAS unsigned long long*)(lds + 155648 + 4096))[idx];
    const unsigned lo = __builtin_amdgcn_readfirstlane((unsigned)v), hi = __builtin_amdgcn_readfirstlane((unsigned)(v >> 32));
    return (const float*)(const GAS float*)(((unsigned long long)hi << 32) | lo);
}
#define VM_WAIT() asm volatile("s_waitcnt vmcnt(0)" ::: "memory")

namespace pg8 {
constexpr int BM = 256, BK = 64, HALF = 128, HTB = HALF * BK * 2, STAGE_BYTES = 8 * HTB, NXCD = 8, WGM = 8, KD = 1024, NT = KD / BK;
__host__ __device__ __forceinline__ int lds_byte(int r, int c) { const int st = (r >> 4) * 2 + (c >> 5), rr = r & 15, cc = c & 31, ob = rr * 64 + cc * 2; return st * 1024 + (ob ^ (((ob >> 9) & 1) << 5)); }
__host__ __device__ __forceinline__ void stage_rc(int b, int& R, int& C) { const int st = b / 1024, sb = b % 1024, swz = sb ^ (((sb >> 9) & 1) << 5); R = (st >> 1) * 16 + swz / 64; C = (st & 1) * 32 + (swz % 64) / 2; }
__host__ __device__ __forceinline__ int perm32(int rho) { const int n = rho >> 4, i = rho & 15; return 8 * (i >> 2) + 4 * n + (i & 3); }

struct Unit { int arow0, pm, pn, aux, trow, nval; const char* bptr; };

struct StaticOrder {
    int nM, nN, nwg, G, c; const char* Bt;
    __device__ void init(int M, int N, int G_, int c_, const bf16_t* Bt_) { nM = M / BM; nN = N / BM; nwg = nM * nN; G = G_; c = c_; Bt = (const char*)Bt_; }
    __device__ bool next(int i, Unit& u) const {
        const long L = (long)i * G + c; if (L >= nwg) return false;
        int wgid = (int)L; { const int q = nwg / NXCD, r = nwg % NXCD, xcd = wgid % NXCD, off = wgid / NXCD; wgid = (xcd < r ? xcd * (q + 1) : r * (q + 1) + (xcd - r) * q) + off; }
        const int nig = WGM * nN, gid = wgid / nig, fm = gid * WGM, gsz = (nM - fm) < WGM ? (nM - fm) : WGM;
        u.pm = fm + ((wgid % nig) % gsz); u.pn = (wgid % nig) / gsz; u.arow0 = u.pm * BM; u.aux = 0; u.trow = 0; u.nval = 0; u.bptr = Bt + (size_t)u.pn * BM * KD * 2; return true;
    }
};
struct IdentityRows { __device__ __forceinline__ int row(const Unit& u, int r) const { return u.arow0 + r; } };
struct TableRows { const int* tab; __device__ __forceinline__ int row(const Unit& u, int r) const { return r < u.nval ? tab[u.trow + r] : 0; } };

typedef int v8i_t __attribute__((ext_vector_type(8)));
template <bool F8 = false, class Epi, class Sched, class RowMap>
__device__ __forceinline__ void gemm_phase(LAS unsigned char* lds, const void* Abase, const Sched& S, const RowMap& RM, const Epi& E) {
    constexpr int PITCH = F8 ? KD : KD * 2, NTK = F8 ? KD / 128 : KD / BK;
    int tid = threadIdx.x; asm volatile("" : "+v"(tid)); tid &= 511;
    const int wid = __builtin_amdgcn_readfirstlane(tid >> 6), lane = tid & 63, wr = wid >> 2, wc = wid & 3, fr = lane & 15, fq = lane >> 4;
    int Rr[2], Cc[2]; unsigned voffB[2];
#pragma unroll
    for (int i = 0; i < 2; ++i) { int R, C; stage_rc(tid * 16 + i * 8192, R, C); int Rb = Epi::PERM ? ((R & ~31) + perm32(R & 31)) : R;
        if constexpr (Epi::PERM16) Rb = 64 * (R >> 5) + 16 * ((R >> 2) & 3) + 4 * ((R >> 4) & 1) + (R & 3);
        Rr[i] = R; Cc[i] = C; voffB[i] = (unsigned)(Rb * PITCH + C * 2); }
    constexpr size_t kstep = (size_t)(BK * 2);
    constexpr size_t hstep = (size_t)(Epi::PERM16 ? 8 : HALF) * PITCH;
    const unsigned ldsw = (unsigned)wid * 1024u;
    const int aoff = F8 ? lds_byte(wr * 64 + fr, fq * 16) : lds_byte(wr * 64 + fr, fq * 8), boff = F8 ? lds_byte(wc * 32 + fr, fq * 16) : lds_byte(wc * 32 + fr, fq * 8);
    const int aoff1 = F8 ? lds_byte(wr * 64 + fr, fq * 16 + 8) : aoff + 1024, boff1 = F8 ? lds_byte(wc * 32 + fr, fq * 16 + 8) : boff + 1024;
    const unsigned lds0 = (unsigned)(unsigned long long)lds;
    unsigned abase0 = lds0 + (unsigned)aoff, bbase0 = lds0 + 65536u + (unsigned)boff;
    asm volatile("" : "+v"(abase0), "+v"(bbase0));
    const unsigned abase1 = abase0 + (F8 ? 16u : 1024u), bbase1 = bbase0 + (F8 ? 16u : 1024u); (void)aoff1; (void)boff1;
#define PG8_SA(b, h) (((b) * 2 + (h)) * HTB)
#define PG8_SB(b, h) ((4 + (b) * 2 + (h)) * HTB)
#define PG8_STAGE(bufoff, gbase, voff) do { _Pragma("unroll") for (int _i = 0; _i < 2; ++_i) { unsigned _keep; \
        asm volatile("s_mov_b32 %0, m0\n\ts_mov_b32 m0, %3\n\ts_nop 0\n\tglobal_load_lds_dwordx4 %1, %2\n\ts_mov_b32 m0, %0" : "=&s"(_keep) : "v"((voff)[_i]), "s"((const char*)(gbase)), \
                     "s"((unsigned)__builtin_amdgcn_readfirstlane((int)(unsigned)(unsigned long long)(lds + (bufoff) + ldsw + _i * 8192))) : "memory"); } } while (0)
#define PG8_RDA(base, off) (*(const LAS u32x4*)(size_t)((base) + (unsigned)(off)))
#define PG8_LDA(dst, b, h) do { _Pragma("unroll") for (int m = 0; m < 4; ++m) { if constexpr (F8) { const u32x4 _lo = PG8_RDA(abase0, PG8_SA(b, h) + m * 2048), _hi = PG8_RDA(abase1, PG8_SA(b, h) + m * 2048); \
        dst##8[m] = (v8i_t){(int)_lo.x, (int)_lo.y, (int)_lo.z, (int)_lo.w, (int)_hi.x, (int)_hi.y, (int)_hi.z, (int)_hi.w}; } \
        else { _Pragma("unroll") for (int k = 0; k < 2; ++k) dst[m][k] = __builtin_bit_cast(bf16x8, PG8_RDA(abase0, PG8_SA(b, h) + m * 2048 + k * 1024)); } } } while (0)
#define PG8_LDB(dst, b, h) do { _Pragma("unroll") for (int n = 0; n < 2; ++n) { if constexpr (F8) { const u32x4 _lo = PG8_RDA(bbase0, PG8_SB(b, h) - 65536 + n * 2048), _hi = PG8_RDA(bbase1, PG8_SB(b, h) - 65536 + n * 2048); \
        dst##8[n] = (v8i_t){(int)_lo.x, (int)_lo.y, (int)_lo.z, (int)_lo.w, (int)_hi.x, (int)_hi.y, (int)_hi.z, (int)_hi.w}; } \
        else { _Pragma("unroll") for (int k = 0; k < 2; ++k) dst[n][k] = __builtin_bit_cast(bf16x8, PG8_RDA(bbase0, PG8_SB(b, h) - 65536 + n * 2048 + k * 1024)); } } } while (0)
#define PG8_MMA(ai, bj, At, Bt) do { __builtin_amdgcn_s_setprio(1); _Pragma("unroll") for (int m = 0; m < 4; ++m) _Pragma("unroll") for (int n = 0; n < 2; ++n) { \
        if constexpr (F8) acc[ai][bj][m][n] = __builtin_amdgcn_mfma_scale_f32_16x16x128_f8f6f4(Bt##8[n], At##8[m], acc[ai][bj][m][n], 0, 0, 0, 0, 0, 0);     \
        else { _Pragma("unroll") for (int k = 0; k < 2; ++k) acc[ai][bj][m][n] = __builtin_amdgcn_mfma_f32_16x16x32_bf16(Bt[n][k], At[m][k], acc[ai][bj][m][n], 0, 0, 0); } } __builtin_amdgcn_s_setprio(0); } while (0)
#define PG8_WAIT_V(n) asm volatile("s_waitcnt vmcnt(" #n ")" ::: "memory")
#define PG8_WAIT_L(n) asm volatile("s_waitcnt lgkmcnt(" #n ")" ::: "memory")
#define PG8_BAR __builtin_amdgcn_s_barrier()
#define PG8_SCHED __builtin_amdgcn_sched_barrier(0)
#define PG8_ROWS(v, u) do { int _t = threadIdx.x; asm volatile("" : "+v"(_t)); _t &= 511; _Pragma("unroll") for (int _i = 0; _i < 2; ++_i) { int _R, _C; stage_rc(_t * 16 + _i * 8192, _R, _C); \
        _Pragma("unroll") for (int _h = 0; _h < 2; ++_h) v[_h][_i] = (unsigned)RM.row((u), _h * HALF + _R) * (unsigned)PITCH + (unsigned)_C * 2u; } } while (0)
    Unit cur, nxt; int ui = 0;
    if (!S.next(0, cur)) return;
    unsigned vc[2][2];
    PG8_ROWS(vc, cur);
#define PG8_VNSLOT ((LAS u32x4*)(lds + 131072) + (threadIdx.x & 511))
    f32x4 acc[2][2][4][2];
#pragma unroll
    for (int a = 0; a < 2; ++a)
#pragma unroll
        for (int b = 0; b < 2; ++b)
#pragma unroll
            for (int m = 0; m < 4; ++m)
#pragma unroll
                for (int n = 0; n < 2; ++n) acc[a][b][m][n] = (f32x4){0.f, 0.f, 0.f, 0.f};
    bf16x8 At[4][2], B0[2][2], B1[2][2]; v8i_t At8[4], B08[2], B18[2];
    const char* cA = (const char*)Abase; const char* cB = cur.bptr;
    PG8_STAGE(PG8_SB(0, 0), cB, voffB); PG8_STAGE(PG8_SB(0, 1), cB + hstep, voffB); PG8_STAGE(PG8_SA(0, 0), cA, vc[0]); PG8_STAGE(PG8_SA(0, 1), cA, vc[1]);
    if (wr == 1) PG8_BAR;
    PG8_WAIT_V(2); PG8_BAR;
    PG8_STAGE(PG8_SB(1, 0), cB + kstep, voffB); PG8_STAGE(PG8_SA(1, 0), cA + kstep, vc[0]); PG8_STAGE(PG8_SB(1, 1), cB + hstep + kstep, voffB);
    PG8_WAIT_V(6); PG8_BAR;
    for (;;) {
        const bool has_next = S.next(ui + 1, nxt);
        { unsigned vn[2][2];
          if (has_next) { PG8_ROWS(vn, nxt); } else {
#pragma unroll
            for (int h = 0; h < 2; ++h)
#pragma unroll
                for (int i = 0; i < 2; ++i) vn[h][i] = vc[h][i]; }
          *PG8_VNSLOT = (u32x4){vn[0][0], vn[0][1], vn[1][0], vn[1][1]}; }
        const char* nB = has_next ? nxt.bptr : cB;
#pragma unroll 1
        for (int t = 0; t < NTK; t += 2) {
            const bool last = (t == NTK - 2);
            const char* a1 = cA + (size_t)(t + 1) * kstep;
            const char* a2 = last ? cA : cA + (size_t)(t + 2) * kstep; const char* b2 = last ? nB : cB + (size_t)(t + 2) * kstep;
            const char* a3 = a2 + kstep; const char* b3 = b2 + kstep;

            PG8_LDB(B0, 0, 0); PG8_LDB(B1, 0, 1); PG8_SCHED; PG8_LDA(At, 0, 0); PG8_STAGE(PG8_SA(1, 1), a1, vc[1]);
            if (last) { const u32x4 q = *PG8_VNSLOT; vc[0][0] = q.x; vc[0][1] = q.y; vc[1][0] = q.z; vc[1][1] = q.w; }
            PG8_WAIT_V(8); PG8_WAIT_L(0); PG8_BAR; PG8_MMA(0, 0, At, B0); PG8_MMA(0, 1, At, B1); PG8_BAR; PG8_SCHED;
            PG8_LDA(At, 0, 1); PG8_STAGE(PG8_SB(0, 0), b2, voffB); PG8_STAGE(PG8_SB(0, 1), b2 + hstep, voffB); PG8_STAGE(PG8_SA(0, 0), a2, vc[0]);
            PG8_WAIT_V(8); PG8_WAIT_L(0); PG8_BAR; PG8_MMA(1, 0, At, B0); PG8_MMA(1, 1, At, B1); PG8_BAR; PG8_SCHED;
            PG8_LDB(B0, 1, 0); PG8_LDB(B1, 1, 1); PG8_SCHED; PG8_LDA(At, 1, 0); PG8_STAGE(PG8_SA(0, 1), a2, vc[1]);
            PG8_WAIT_V(8); PG8_WAIT_L(0); PG8_BAR; PG8_MMA(0, 0, At, B0); PG8_MMA(0, 1, At, B1); PG8_BAR; PG8_SCHED;
            PG8_LDA(At, 1, 1); PG8_STAGE(PG8_SB(1, 0), b3, voffB); PG8_STAGE(PG8_SB(1, 1), b3 + hstep, voffB); PG8_STAGE(PG8_SA(1, 0), a3, vc[0]);
            PG8_WAIT_V(8); PG8_WAIT_L(0); PG8_BAR; PG8_MMA(1, 0, At, B0); PG8_MMA(1, 1, At, B1); PG8_BAR; PG8_SCHED;
        }
        if (wr == 0) PG8_BAR;
        { int _t = threadIdx.x; asm volatile("" : "+v"(_t)); _t &= 511; const int _l = _t & 63; E(acc, cur, wr, wc, _l & 15, _l >> 4); }
        if (!has_next) break;
#pragma unroll
        for (int a = 0; a < 2; ++a)
#pragma unroll
            for (int b = 0; b < 2; ++b)
#pragma unroll
                for (int m = 0; m < 4; ++m)
#pragma unroll
                    for (int n = 0; n < 2; ++n) acc[a][b][m][n] = (f32x4){0.f, 0.f, 0.f, 0.f};
        cur = nxt; cB = nB; ++ui;
        if (wr == 1) PG8_BAR;
    }
    PG8_WAIT_V(0);
    PG8_BAR;
#undef PG8_SA
#undef PG8_SB
#undef PG8_STAGE
#undef PG8_LDA
#undef PG8_LDB
#undef PG8_MMA
#undef PG8_RDA
#undef PG8_WAIT_V
#undef PG8_WAIT_L
#undef PG8_BAR
#undef PG8_SCHED
#undef PG8_ROWS
#undef PG8_VNSLOT
}

struct EpiProj {
    static constexpr bool PERM = true, PERM16 = false;
    bf16_t* O; const f32x2* rope;
    __device__ __forceinline__ void operator()(const f32x4 (&acc)[2][2][4][2], const Unit& u, int wr, int wc, int fr, int fq) const {
        const int row0 = u.pm * BM + wr * 64 + fr, col0 = u.pn * BM + wc * 32 + 8 * fq;
        const bool rot = u.pn < 4; const float sc = u.pn < 2 ? 0.125f * 1.4426950408889634f : 1.0f;
        const int j0 = 16 * (wc & 1) + 4 * fq;
#pragma unroll
        for (int ai = 0; ai < 2; ++ai)
#pragma unroll
            for (int m = 0; m < 4; ++m) {
                const int row = row0 + ai * HALF + m * 16; bf16_t* rowp = O + (size_t)row * PROJW + col0;
                f32x4 cs0 = (f32x4){1.f, 0.f, 1.f, 0.f}, cs1 = cs0;
                if (rot) { const f32x4* rp = (const f32x4*)(rope + (size_t)(row & (SEQ - 1)) * 32 + j0); cs0 = rp[0]; cs1 = rp[1]; }
#pragma unroll
                for (int bj = 0; bj < 2; ++bj) {
                    f32x4 v0 = acc[ai][bj][m][0], v1 = acc[ai][bj][m][1];
                    if (rot) {
                        const f32x4 a = v0, b = v1;
                        v0[0] = a[0] * cs0[0] - a[1] * cs0[1]; v0[1] = a[1] * cs0[0] + a[0] * cs0[1];
                        v0[2] = a[2] * cs0[2] - a[3] * cs0[3]; v0[3] = a[3] * cs0[2] + a[2] * cs0[3];
                        v1[0] = b[0] * cs1[0] - b[1] * cs1[1]; v1[1] = b[1] * cs1[0] + b[0] * cs1[1];
                        v1[2] = b[2] * cs1[2] - b[3] * cs1[3]; v1[3] = b[3] * cs1[2] + b[2] * cs1[3];
                    }
                    v0 = v0 * sc; v1 = v1 * sc;
                    u32x4 w; w.x = cvt_pk_bf16(v0[0], v0[1]); w.y = cvt_pk_bf16(v0[2], v0[3]); w.z = cvt_pk_bf16(v1[0], v1[1]); w.w = cvt_pk_bf16(v1[2], v1[3]);
                    *(u32x4*)(rowp + bj * HALF) = w; }
            }
    }
};
struct EpiOut {
    static constexpr bool PERM = true, PERM16 = false;
    const bf16_t* X; bf16_t* O;
    __device__ __forceinline__ void operator()(const f32x4 (&acc)[2][2][4][2], const Unit& u, int wr, int wc, int fr, int fq) const {
        const int col0 = u.pn * BM + wc * 32 + 8 * fq;
#pragma unroll
        for (int ai = 0; ai < 2; ++ai)
#pragma unroll
            for (int m = 0; m < 4; ++m) { const size_t off = (size_t)(u.pm * BM + ai * HALF + wr * 64 + m * 16 + fr) * DM + col0;
#pragma unroll
                for (int bj = 0; bj < 2; ++bj) { const u32x4 xw = *(const u32x4*)(X + off + bj * HALF);
                    const f32x4 x0 = (f32x4){bflo(xw.x), bfhi(xw.x), bflo(xw.y), bfhi(xw.y)}, x1 = (f32x4){bflo(xw.z), bfhi(xw.z), bflo(xw.w), bfhi(xw.w)};
                    const f32x4 v0 = x0 * ALPHA + acc[ai][bj][m][0], v1 = x1 * ALPHA + acc[ai][bj][m][1];
                    u32x4 w; w.x = cvt_pk_bf16(v0[0], v0[1]); w.y = cvt_pk_bf16(v0[2], v0[3]); w.z = cvt_pk_bf16(v1[0], v1[1]); w.w = cvt_pk_bf16(v1[2], v1[3]);
                    *(u32x4*)(O + off + bj * HALF) = w; } }
    }
};
struct EpiAct {
    static constexpr bool PERM = true, PERM16 = false;
    unsigned char* O; const float* bg; const float* bu; float osc;
    __device__ __forceinline__ void operator()(const f32x4 (&acc)[2][2][4][2], const Unit& u, int wr, int wc, int fr, int fq) const {
        const int ec0 = u.pn * HALF + wc * 32 + 8 * fq;
        const float* bgp = bg + u.aux * 1024 + ec0; const float* bup = bu + u.aux * 1024 + ec0;
        const f32x4 g0b = *(const f32x4*)bgp, g1b = *(const f32x4*)(bgp + 4), u0b = *(const f32x4*)bup, u1b = *(const f32x4*)(bup + 4);
#pragma unroll
        for (int ai = 0; ai < 2; ++ai)
#pragma unroll
            for (int m = 0; m < 4; ++m) {
                const int row = u.pm * BM + ai * HALF + wr * 64 + m * 16 + fr;
                const f32x4 g[2] = {acc[ai][0][m][0] * osc + g0b, acc[ai][0][m][1] * osc + g1b}, uu[2] = {acc[ai][1][m][0] * osc + u0b, acc[ai][1][m][1] * osc + u1b}; float r[8];
#pragma unroll
                for (int n = 0; n < 2; ++n)
#pragma unroll
                    for (int e = 0; e < 4; e += 2) {
                        const f32x2 gv = (f32x2){fminf(g[n][e], 7.0f), fminf(g[n][e + 1], 7.0f)};
                        const f32x2 uv = (f32x2){__builtin_amdgcn_fmed3f(uu[n][e], -7.0f, 7.0f), __builtin_amdgcn_fmed3f(uu[n][e + 1], -7.0f, 7.0f)};
                        const f32x2 t2 = gv * (-1.702f * 1.4426950408889634f);
                        const f32x2 d2 = (f32x2){__builtin_amdgcn_exp2f(t2[0]), __builtin_amdgcn_exp2f(t2[1])} + 1.0f;
                        const f32x2 r2 = (f32x2){__builtin_amdgcn_rcpf(d2[0]), __builtin_amdgcn_rcpf(d2[1])};
                        const f32x2 o2 = __builtin_elementwise_fma(uv, (f32x2){F8_SCALE_A, F8_SCALE_A}, (f32x2){F8_SCALE_A, F8_SCALE_A}) * (gv * r2);
                        r[4 * n + e] = o2[0]; r[4 * n + e + 1] = o2[1]; }
                int lo = __builtin_amdgcn_cvt_pk_fp8_f32(r[0], r[1], 0, false); lo = __builtin_amdgcn_cvt_pk_fp8_f32(r[2], r[3], lo, true);
                int hi = __builtin_amdgcn_cvt_pk_fp8_f32(r[4], r[5], 0, false); hi = __builtin_amdgcn_cvt_pk_fp8_f32(r[6], r[7], hi, true);
                *(u32x2*)(O + (size_t)row * 1024 + ec0) = (u32x2){(unsigned)lo, (unsigned)hi};
            }
    }
};
struct EpiY {
    static constexpr bool PERM = false, PERM16 = true;
    unsigned char* O; const float* bd; float osc;
    __device__ __forceinline__ void operator()(const f32x4 (&acc)[2][2][4][2], const Unit& u, int wr, int wc, int fr, int fq) const {
        const int col0 = u.pn * BM + wc * 64 + 16 * fq; const float* bp = bd + u.aux * 1024 + col0;
        f32x4 bv[2][2];
#pragma unroll
        for (int bj = 0; bj < 2; ++bj)
#pragma unroll
            for (int n = 0; n < 2; ++n) bv[bj][n] = *(const f32x4*)(bp + 8 * bj + 4 * n) * F8_SCALE_Y;
        const float os = osc * F8_SCALE_Y;
#pragma unroll
        for (int ai = 0; ai < 2; ++ai)
#pragma unroll
            for (int m = 0; m < 4; ++m) { unsigned char* rowp = O + (size_t)(u.pm * BM + ai * HALF + wr * 64 + m * 16 + fr) * 1024 + col0; u32x4 w;
#pragma unroll
                for (int bj = 0; bj < 2; ++bj) { f32x4 v0 = acc[ai][bj][m][0] * os + bv[bj][0], v1 = acc[ai][bj][m][1] * os + bv[bj][1];
#pragma unroll
                    for (int e = 0; e < 4; ++e) { v0[e] = __builtin_amdgcn_fmed3f(v0[e], -448.0f, 448.0f); v1[e] = __builtin_amdgcn_fmed3f(v1[e], -448.0f, 448.0f); }
                    int lo = __builtin_amdgcn_cvt_pk_fp8_f32(v0[0], v0[1], 0, false); lo = __builtin_amdgcn_cvt_pk_fp8_f32(v0[2], v0[3], lo, true);
                    int hi = __builtin_amdgcn_cvt_pk_fp8_f32(v1[0], v1[1], 0, false); hi = __builtin_amdgcn_cvt_pk_fp8_f32(v1[2], v1[3], hi, true);
                    if (bj == 0) { w.x = (unsigned)lo; w.y = (unsigned)hi; } else { w.z = (unsigned)lo; w.w = (unsigned)hi; } }
                *(u32x4*)rowp = w; }
    }
};
struct GroupedOrder {
    int t_lo, ntiles, npn, G, c, seg0; const LAS int* segt; const LAS int* segc; const char* W; size_t estride; int pitch;
    mutable int hint;
    __device__ bool next(int i, Unit& u) const {
        const int L = __builtin_amdgcn_readfirstlane(i * G + c); if (L >= ntiles * npn) return false;
        const int tile = t_lo + L / npn, pn = L % npn;
        int s = hint; while (s < seg0 + 31 && segt[s + 1] <= tile) ++s;
        hint = s;
        u.pm = tile - t_lo; u.pn = pn; u.aux = s & 31; u.arow0 = u.pm * BM; { const int ti = tile - segt[s]; u.trow = (s & 31) * NTOK + ti * BM; u.nval = segc[s & 31] - ti * BM; } u.bptr = W + (size_t)(s & 31) * estride + (size_t)pn * BM * pitch; return true;
    }
};
}


typedef short s16x4 __attribute__((ext_vector_type(4)));
typedef short v4i16_t __attribute__((ext_vector_type(4)));
typedef float f32x16 __attribute__((ext_vector_type(16)));
__device__ __forceinline__ s16x4 vtr(const LAS unsigned char* p) { return __builtin_bit_cast(s16x4, __builtin_amdgcn_ds_read_tr16_b64_v4i16((LAS v4i16_t*)p)); }
__device__ __forceinline__ int crow(int r, int hi) { return (r & 3) + 8 * (r >> 2) + 4 * hi; }
constexpr int ATT_VROW = 144;
constexpr int ATT_WLDS = 32 * ATT_VROW + 512;
constexpr int ATT_KBUF = 384 * 128, ATT_V0 = ATT_KBUF, ATT_SC0 = 3 * ATT_KBUF;
static_assert(ATT_SC0 + NWAVES * 512 <= LDS_MISC, "attention LDS map");
template <int DIL>
__device__ __forceinline__ void attn_kdma(const bf16_t* PROJ, int R, LAS unsigned char* kbuf, int wave, int lane) {
    constexpr int L = SEQ / DIL, TPR = L / 32;
    asm volatile("" : "+v"(lane));
    const int idx0 = 8 * R, bh = idx0 >> 7, w0 = idx0 & 127, b = bh >> 3, h = bh & 7, r = w0 / TPR, M0 = 32 * (w0 % TPR);
#pragma unroll
    for (int n = 0; n < 6; ++n) {
        const int row = 8 * (6 * wave + n) + (lane >> 3); int pos = M0 - 64 + row; pos = pos < 0 ? 0 : (pos > L - 1 ? L - 1 : pos);
        const unsigned voff = ((unsigned)(b * SEQ + pos * DIL + r) * PROJW + COL_K + h * 64) * 2u + (unsigned)(((lane & 7) ^ (lane >> 3)) * 16);
        unsigned keep;
        asm volatile("s_mov_b32 %0, m0\n\ts_mov_b32 m0, %3\n\ts_nop 0\n\tglobal_load_lds_dwordx4 %1, %2\n\ts_mov_b32 m0, %0" : "=&s"(keep) : "v"(voff), "s"((const char*)PROJ),
                     "s"((unsigned)__builtin_amdgcn_readfirstlane((int)(unsigned)(unsigned long long)(kbuf + (6 * wave + n) * 1024))) : "memory"); }
}
template <int DIL>
__device__ __forceinline__ void attn_vdma(const bf16_t* PROJ, int R, LAS unsigned char* vbuf, int wave, int lane) {
    constexpr int L = SEQ / DIL, TPR = L / 32;
    asm volatile("" : "+v"(lane));
    const int idx0 = 8 * R, bh = idx0 >> 7, w0 = idx0 & 127, b = bh >> 3, h = bh & 7, r = w0 / TPR, M0 = 32 * (w0 % TPR);
#pragma unroll
    for (int n = 0; n < 6; ++n) {
        const int row = 8 * (6 * wave + n) + (lane >> 3); int pos = M0 - 64 + row; pos = pos < 0 ? 0 : (pos > L - 1 ? L - 1 : pos);
        const unsigned voff = ((unsigned)(b * SEQ + pos * DIL + r) * PROJW + COL_V + h * 64) * 2u + (unsigned)(((lane & 7) ^ (4 * ((lane >> 4) & 1))) * 16);
        unsigned keep;
        asm volatile("s_mov_b32 %0, m0\n\ts_mov_b32 m0, %3\n\ts_nop 0\n\tglobal_load_lds_dwordx4 %1, %2\n\ts_mov_b32 m0, %0" : "=&s"(keep) : "v"(voff), "s"((const char*)PROJ),
                     "s"((unsigned)__builtin_amdgcn_readfirstlane((int)(unsigned)(unsigned long long)(vbuf + (6 * wave + n) * 1024))) : "memory"); }
}
template <int DIL>
__device__ __forceinline__ void attn_qload(const bf16_t* PROJ, int idx, int lane, bf16x8 (&q)[4]) {
    constexpr int TPR = SEQ / DIL / 32;
    const int bh = idx >> 7, w = idx & 127, b = bh >> 3, h = bh & 7, r = w / TPR, m0 = 32 * (w % TPR), i = lane & 31, hi = lane >> 5;
    const unsigned qo = ((unsigned)(b * SEQ + (m0 + i) * DIL + r) * PROJW + COL_Q + h * 64 + 8 * hi) * 2u;
#pragma unroll
    for (int s = 0; s < 4; ++s) q[s] = *(const bf16x8*)((const char*)PROJ + qo + 32 * s);
}
template <int DIL, bool FIRST>
__device__ __forceinline__ void attn_task(bf16_t* PROJ, bf16_t* ATTO, float* ML, int b, int h, int r, int m0, LAS unsigned char* wl, LAS unsigned char* kimg, const LAS unsigned char* vimg, const bf16x8 (&qf)[4],
                                          int wave, int Rnext, int lane) {
    constexpr int L = SEQ / DIL;
    asm volatile("" : "+v"(lane)); lane &= 63;
    const int i = lane & 31, hi = lane >> 5;
    const char* PB = (const char*)PROJ;
    const unsigned tokq = (unsigned)(b * SEQ + (m0 + i) * DIL + r);
    const LAS unsigned char* krow = kimg + (32 * wave + i) * 128;
    float* mlp = (float*)((char*)ML + (tokq * NH + h) * 8u);
    float mp = 0.f, lp = 0.f;
    if (!FIRST) { mp = mlp[0]; lp = mlp[1]; }
    f32x16 S[5];
#pragma unroll
    for (int kb = 0; kb < 5; ++kb) {
        const int mk0 = m0 - 64 + 32 * kb; const bool inr = (mk0 >= 0 && mk0 < L);
        f32x16 acc;
#pragma unroll
        for (int rr = 0; rr < 16; ++rr) acc[rr] = 0.f;
#pragma unroll
        for (int s = 0; s < 4; ++s) { const bf16x8 kf = *(const LAS bf16x8*)(krow + kb * 4096 + (((2 * s + hi) ^ (i & 7)) * 16)); acc = __builtin_amdgcn_mfma_f32_32x32x16_bf16(kf, qf[s], acc, 0, 0, 0); }
        if (kb == 0 || kb == 4) {
#pragma unroll
            for (int rr = 0; rr < 16; ++rr) { const bool ok = inr && (kb == 0 ? (crow(rr, hi) >= i) : (crow(rr, hi) <= i)); S[kb][rr] = ok ? acc[rr] : -INFINITY; }
        } else {
#pragma unroll
            for (int rr = 0; rr < 16; ++rr) S[kb][rr] = inr ? acc[rr] : -INFINITY; }
    }
    asm volatile("s_waitcnt lgkmcnt(0)" ::: "memory");
    __builtin_amdgcn_s_barrier();
    if (Rnext >= 0) attn_kdma<DIL>(PROJ, Rnext, kimg, wave, lane);
    unsigned dmy = 0u;
    if (FIRST) dmy = *(const volatile unsigned*)(PB + tokq * (unsigned)(PROJW * 2));
    char* OB = (char*)ATTO; const unsigned oo = ((unsigned)(b * SEQ + m0 * DIL + r) * 512 + h * 64 + i) * 2u;
    unsigned short pv0[16], pv1[16];
    if (!FIRST) {
#pragma unroll
        for (int rr = 0; rr < 16; ++rr) { const unsigned short* op = (const unsigned short*)(OB + oo + (unsigned)(crow(rr, hi) * DIL * 1024)); pv0[rr] = op[0]; pv1[rr] = op[32]; } }
    float mx = -INFINITY;
#pragma unroll
    for (int kb = 0; kb < 5; ++kb)
#pragma unroll
        for (int rr = 0; rr < 16; ++rr) mx = fmaxf(mx, S[kb][rr]);
    mx = fmaxf(mx, lane_xor_f<32>(mx, lane));
    float lsum = 0.f;
#pragma unroll
    for (int kb = 0; kb < 5; ++kb)
#pragma unroll
        for (int rr = 0; rr < 16; ++rr) { const float pv = __builtin_amdgcn_exp2f(S[kb][rr] - mx); S[kb][rr] = pv; lsum += pv; }
    lsum += lane_xor_f<32>(lsum, lane);
    f32x16 O[2];
#pragma unroll
    for (int rr = 0; rr < 16; ++rr) { O[0][rr] = 0.f; O[1][rr] = 0.f; }
    const int q4 = (lane & 15) >> 2, p4 = lane & 3, blk = (lane >> 4) & 1;
    const LAS unsigned char* vrd = vimg + (32 * wave + 4 * hi + q4) * 128 + (16 * blk + 4 * p4) * 2;
    const int vfl = 64 * ((q4 >> 1) & 1);
#pragma unroll
    for (int kb = 0; kb < 5; ++kb) {
#pragma unroll
        for (int s = 0; s < 2; ++s) {
            u32x4 pw; pw.x = cvtpk(S[kb][8 * s], S[kb][8 * s + 1]); pw.y = cvtpk(S[kb][8 * s + 2], S[kb][8 * s + 3]); pw.z = cvtpk(S[kb][8 * s + 4], S[kb][8 * s + 5]); pw.w = cvtpk(S[kb][8 * s + 6], S[kb][8 * s + 7]);
            const bf16x8 pa = __builtin_bit_cast(bf16x8, pw);
#pragma unroll
            for (int dh = 0; dh < 2; ++dh) {
                const s16x4 lo = vtr(vrd + (32 * kb + 16 * s) * 128 + ((64 * dh) ^ vfl)), hh = vtr(vrd + (32 * kb + 16 * s + 8) * 128 + ((64 * dh) ^ vfl));
                const bf16x8 vf = (bf16x8){lo[0], lo[1], lo[2], lo[3], hh[0], hh[1], hh[2], hh[3]};
                O[dh] = __builtin_amdgcn_mfma_f32_32x32x16_bf16(pa, vf, O[dh], 0, 0, 0);
            }
        }
    }
    float fprev = 0.f, fcur;
    if (FIRST) { fcur = 1.0f / lsum; if (hi == 0) { mlp[0] = mx; mlp[1] = lsum; } }
    else { const float mn = fmaxf(mp, mx); const float aa = __builtin_amdgcn_exp2f(mp - mn) * lp, cc = __builtin_amdgcn_exp2f(mx - mn);
        const float ln = aa + cc * lsum; const float il = 1.0f / ln; fprev = aa * il; fcur = cc * il; if (hi == 0) { mlp[0] = mn; mlp[1] = ln; } }
    LAS float* sc = (LAS float*)wl;
    if (hi == 0) { sc[i] = fprev; sc[32 + i] = fcur; }
    asm volatile("s_waitcnt lgkmcnt(0)" ::: "memory");
#pragma unroll
    for (int rr = 0; rr < 16; ++rr) { const int q = crow(rr, hi); const float fc = sc[32 + q]; bf16_t* op = (bf16_t*)(OB + oo + (unsigned)(q * DIL * 1024));
        float v0 = O[0][rr] * fc, v1 = O[1][rr] * fc;
        if (!FIRST) { const float fp = sc[q]; v0 += __uint_as_float((unsigned)pv0[rr] << 16) * fp; v1 += __uint_as_float((unsigned)pv1[rr] << 16) * fp; }
        op[0] = (bf16_t)f2bf(v0); op[32] = (bf16_t)f2bf(v1); }
    if (FIRST) asm volatile("" :: "v"(dmy));
    asm volatile("s_waitcnt lgkmcnt(0)" ::: "memory");
}
template <int DIL, bool FIRST>
__device__ __forceinline__ void attn_pass(bf16_t* PROJ, bf16_t* ATTO, float* ML, LAS unsigned char* lds, int vcu, int G, int wave, int lane) {
    constexpr int TPR = SEQ / DIL / 32;
    constexpr int NROUND = BATCH * NH * 128 / 8;
    const int per = (NROUND + G - 1) / G, R0 = vcu * per, R1 = (R0 + per < NROUND) ? R0 + per : NROUND;
    if (R0 >= R1) return;
    LAS unsigned char* wl = lds + ATT_SC0 + wave * 512;
    __syncthreads();
    attn_kdma<DIL>(PROJ, R0, lds, wave, lane); attn_vdma<DIL>(PROJ, R0, lds + ATT_V0, wave, lane);
    bf16x8 qn[4]; attn_qload<DIL>(PROJ, 8 * R0 + wave, lane, qn);
    asm volatile("s_waitcnt vmcnt(0)" ::: "memory");
    for (int R = R0; R < R1; ++R) {
        __builtin_amdgcn_s_barrier();
        bf16x8 qf[4];
#pragma unroll
        for (int s = 0; s < 4; ++s) qf[s] = qn[s];
        const bool more = R + 1 < R1;
        if (more) { attn_vdma<DIL>(PROJ, R + 1, lds + ATT_V0 + ((R + 1 - R0) & 1) * ATT_KBUF, wave, lane); attn_qload<DIL>(PROJ, 8 * (R + 1) + wave, lane, qn); }
        const int idx = 8 * R + wave, bh = idx >> 7, w = idx & 127;
        attn_task<DIL, FIRST>(PROJ, ATTO, ML, bh >> 3, bh & 7, w / TPR, 32 * (w % TPR), wl, lds, lds + ATT_V0 + ((R - R0) & 1) * ATT_KBUF, qf, wave, more ? R + 1 : -1, lane); }
    __syncthreads();
}


constexpr int SSD_RS = 272, SSD_RSX = 528;
constexpr int SL_C = 0, SL_B = 34816, SL_X = 69632, SL_TAB = 137216;
static_assert(SL_TAB + 8192 <= LDS_MISC, "SSD LDS map");
__device__ __forceinline__ float bfx(short v) { return __uint_as_float((unsigned)(unsigned short)v << 16); }
__device__ __forceinline__ bf16x8 frag_tr(const LAS unsigned char* img, int RS, int k0, int n0, int lane) {
    const int h2 = lane >> 5, blk = (lane >> 4) & 1, q4 = (lane & 15) >> 2, p4 = lane & 3;
    const LAS unsigned char* p = img + (k0 + 8 * h2 + q4) * RS + (n0 + 16 * blk + 4 * p4) * 2;
    const s16x4 lo = vtr(p), hi = vtr(p + 4 * RS);
    return (bf16x8){lo[0], lo[1], lo[2], lo[3], hi[0], hi[1], hi[2], hi[3]};
}
__device__ __forceinline__ bf16x8 frag_row(const LAS unsigned char* img, int RS, int r0, int k0, int lane) {
    return *(const LAS bf16x8*)(img + (r0 + (lane & 31)) * RS + (k0 + 8 * (lane >> 5)) * 2);
}
__device__ __forceinline__ float ssd_stage(const bf16_t* XBC2, const float* DT, const float* alog_f, const float* alog_b, const float* dtb_f, const float* dtb_b,
                                           int b, int c, int g, bool needC, LAS unsigned char* lds, int tid, int wave, int lane) {
    const size_t t0 = (size_t)b * SEQ + 128 * c;
    {
        const char* XB = (const char*)XBC2 + t0 * 2048;
        u32x4 vb[4], vc[4], vx[8];
#pragma unroll
        for (int k = 0; k < 4; ++k) { const int i = tid + k * NTHREADS, row = i >> 4, pc = i & 15;
            vb[k] = *(const u32x4*)(XB + (unsigned)(row * 2048 + (512 + 128 * g + 8 * pc) * 2));
            if (needC) vc[k] = *(const u32x4*)(XB + (unsigned)(row * 2048 + (768 + 128 * g + 8 * pc) * 2)); }
#pragma unroll
        for (int k = 0; k < 8; ++k) { const int i = tid + k * NTHREADS, row = i >> 5, pc = i & 31; vx[k] = *(const u32x4*)(XB + (unsigned)(row * 2048 + (256 * g + 8 * pc) * 2)); }
#pragma unroll
        for (int k = 0; k < 4; ++k) { const int i = tid + k * NTHREADS, row = i >> 4, pc = i & 15;
            *(LAS u32x4*)(lds + SL_B + row * SSD_RS + pc * 16) = vb[k];
            if (needC) *(LAS u32x4*)(lds + SL_C + row * SSD_RS + pc * 16) = vc[k]; }
#pragma unroll
        for (int k = 0; k < 8; ++k) { const int i = tid + k * NTHREADS, row = i >> 5, pc = i & 31; *(LAS u32x4*)(lds + SL_X + row * SSD_RSX + pc * 16) = vx[k]; }
    }
    const int hh = wave & 3, dir = wave >> 2, h = 4 * g + hh;
    const float A = -expf(dir ? alog_b[h] : alog_f[h]), bias = dir ? dtb_b[h] : dtb_f[h];
    const int s0 = 2 * lane;
    const float r0 = DT[(t0 + s0) * 16 + dir * 8 + h] + bias, r1 = DT[(t0 + s0 + 1) * 16 + dir * 8 + h] + bias;
    const float d0 = r0 > 20.f ? r0 : log1pf(expf(r0)), d1 = r1 > 20.f ? r1 : log1pf(expf(r1));
    const float a0 = d0 * A, a1 = d1 * A, ps = a0 + a1;
    float x = ps;
#pragma unroll
    for (int off = 1; off < 64; off <<= 1) { const float y = __shfl_up(x, off); if (lane >= off) x += y; }
    const float total = __shfl(x, 63), excl = x - ps;
    LAS float* tab = (LAS float*)(lds + SL_TAB + wave * 1024);
    tab[s0] = dir ? total - excl : excl + a0; tab[s0 + 1] = dir ? total - (excl + a0) : x;
    tab[128 + s0] = d0; tab[128 + s0 + 1] = d1;
    return total;
}
__device__ __forceinline__ void ssd_pass_a(const bf16_t* XBC2, const float* DT, bf16_t* ST, float* CD, const float* alog_f, const float* alog_b, const float* dtb_f, const float* dtb_b,
                                           LAS unsigned char* lds, int vcu, int G, int tid, int wave, int lane) {
    for (int unit = vcu; unit < BATCH * 32 * 2; unit += G) {
        const int g = unit & 1, c = (unit >> 1) & 31, b = unit >> 6;
        const float total = ssd_stage(XBC2, DT, alog_f, alog_b, dtb_f, dtb_b, b, c, g, false, lds, tid, wave, lane);
        __syncthreads();
        const int hh = wave & 3, dir = wave >> 2, h = 4 * g + hh, h2 = lane >> 5, hi = h2;
        const size_t sidx = (((size_t)b * 32 + c) * 2 + dir) * 8 + h;
        if (lane == 0) CD[sidx] = expf(total);
        const LAS float* cs = (const LAS float*)(lds + SL_TAB + wave * 1024); const LAS float* dtv = cs + 128;
        f32x16 acc[4][2];
#pragma unroll
        for (int nt = 0; nt < 4; ++nt)
#pragma unroll
            for (int pt = 0; pt < 2; ++pt)
#pragma unroll
                for (int rr = 0; rr < 16; ++rr) acc[nt][pt][rr] = 0.f;
#pragma unroll 2
        for (int ks = 0; ks < 8; ++ks) {
            const f32x4 c0 = *(const LAS f32x4*)(cs + 16 * ks + 8 * h2), c1 = *(const LAS f32x4*)(cs + 16 * ks + 8 * h2 + 4);
            const f32x4 e0 = *(const LAS f32x4*)(dtv + 16 * ks + 8 * h2), e1 = *(const LAS f32x4*)(dtv + 16 * ks + 8 * h2 + 4);
            float sc[8];
#pragma unroll
            for (int j = 0; j < 4; ++j) { sc[j] = e0[j] * __expf(total - c0[j]); sc[4 + j] = e1[j] * __expf(total - c1[j]); }
            bf16x8 xf[2];
#pragma unroll
            for (int pt = 0; pt < 2; ++pt) { const bf16x8 raw = frag_tr(lds + SL_X, SSD_RSX, 16 * ks, 64 * hh + 32 * pt, lane);
                u32x4 w; w.x = cvtpk(bfx(raw[0]) * sc[0], bfx(raw[1]) * sc[1]); w.y = cvtpk(bfx(raw[2]) * sc[2], bfx(raw[3]) * sc[3]); w.z = cvtpk(bfx(raw[4]) * sc[4], bfx(raw[5]) * sc[5]); w.w = cvtpk(bfx(raw[6]) * sc[6], bfx(raw[7]) * sc[7]);
                xf[pt] = __builtin_bit_cast(bf16x8, w); }
#pragma unroll
            for (int nt = 0; nt < 4; ++nt) { const bf16x8 af = frag_tr(lds + SL_B, SSD_RS, 16 * ks, 32 * nt, lane);
#pragma unroll
                for (int pt = 0; pt < 2; ++pt) acc[nt][pt] = __builtin_amdgcn_mfma_f32_32x32x16_bf16(af, xf[pt], acc[nt][pt], 0, 0, 0); }
        }
        bf16_t* sp = ST + sidx * 8192;
#pragma unroll
        for (int nt = 0; nt < 4; ++nt)
#pragma unroll
            for (int pt = 0; pt < 2; ++pt)
#pragma unroll
                for (int rg = 0; rg < 4; ++rg) { u32x2 w; w.x = cvtpk(acc[nt][pt][4 * rg], acc[nt][pt][4 * rg + 1]); w.y = cvtpk(acc[nt][pt][4 * rg + 2], acc[nt][pt][4 * rg + 3]);
                    *(u32x2*)(sp + (32 * pt + (lane & 31)) * 128 + 32 * nt + 8 * rg + 4 * hi) = w; }
        __syncthreads();
    }
}
__device__ __forceinline__ void ssd_pass_b(bf16_t* ST, const float* CD, int gtid, int nthreads) {
    for (int idx = gtid; idx < BATCH * 2 * 8 * 64 * 16; idx += nthreads) {
        const int n8 = idx & 15, p = (idx >> 4) & 63, h = (idx >> 10) & 7, dir = (idx >> 13) & 1, b = idx >> 14;
        const size_t cstride = (size_t)2 * 8 * 8192;
        bf16_t* base = ST + (((size_t)b * 32 * 2 + dir) * 8 + h) * 8192 + p * 128 + 8 * n8;
        const float* cdb = CD + ((size_t)b * 32 * 2 + dir) * 8 + h;
        float run[8];
#pragma unroll
        for (int e = 0; e < 8; ++e) run[e] = 0.f;
#pragma unroll 1
        for (int half = 0; half < 2; ++half) {
            u32x4 w[16]; float dec[16];
#pragma unroll
            for (int i = 0; i < 16; ++i) { const int c = dir ? 31 - (16 * half + i) : 16 * half + i; w[i] = *(const u32x4*)(base + c * cstride); dec[i] = cdb[c * 16]; }
#pragma unroll
            for (int i = 0; i < 16; ++i) { const int c = dir ? 31 - (16 * half + i) : 16 * half + i;
                u32x4 o; o.x = cvtpk(run[0], run[1]); o.y = cvtpk(run[2], run[3]); o.z = cvtpk(run[4], run[5]); o.w = cvtpk(run[6], run[7]); *(u32x4*)(base + c * cstride) = o;
                const float d = dec[i]; run[0] = run[0] * d + bflo(w[i].x); run[1] = run[1] * d + bfhi(w[i].x); run[2] = run[2] * d + bflo(w[i].y); run[3] = run[3] * d + bfhi(w[i].y);
                run[4] = run[4] * d + bflo(w[i].z); run[5] = run[5] * d + bfhi(w[i].z); run[6] = run[6] * d + bflo(w[i].w); run[7] = run[7] * d + bfhi(w[i].w); }
        }
    }
}
constexpr int SSD_RSY = 1040;
__device__ __forceinline__ void ssd_pass_c(const bf16_t* XBC2, const float* DT, const bf16_t* ST, const bf16_t* PROJ, bf16_t* MIX, const float* alog_f, const float* alog_b, const float* dtb_f, const float* dtb_b,
                                           const float* dskip, const float* normw, LAS unsigned char* lds, int vcu, int G, int tid, int wave, int lane) {
    for (int unit = vcu; unit < BATCH * 32 * 2; unit += G) {
        const int g = unit & 1, c = (unit >> 1) & 31, b = unit >> 6;
        const int h2 = lane >> 5, hi = h2, l31 = lane & 31;
        const int hh = wave & 3, lh = wave >> 2, h = 4 * g + hh;
        bf16x8 pf[8][2];
        { const bf16_t* pp = ST + ((((size_t)b * 32 + c) * 2 + 0) * 8 + h) * 8192;
#pragma unroll
          for (int ks = 0; ks < 8; ++ks)
#pragma unroll
              for (int pt = 0; pt < 2; ++pt) pf[ks][pt] = *(const bf16x8*)(pp + (32 * pt + l31) * 128 + 16 * ks + 8 * h2); }
        (void)ssd_stage(XBC2, DT, alog_f, alog_b, dtb_f, dtb_b, b, c, g, true, lds, tid, wave, lane);
        __syncthreads();
        {
            const int lt = wave >> 1; f32x16 cb[2];
#pragma unroll
            for (int q = 0; q < 2; ++q)
#pragma unroll
                for (int rr = 0; rr < 16; ++rr) cb[q][rr] = 0.f;
#pragma unroll 2
            for (int ks = 0; ks < 8; ++ks) { const bf16x8 bf = frag_row(lds + SL_C, SSD_RS, 32 * lt, 16 * ks, lane);
#pragma unroll
                for (int q = 0; q < 2; ++q) { const bf16x8 af = frag_row(lds + SL_B, SSD_RS, 32 * (2 * (wave & 1) + q), 16 * ks, lane); cb[q] = __builtin_amdgcn_mfma_f32_32x32x16_bf16(af, bf, cb[q], 0, 0, 0); } }
            __syncthreads();
#pragma unroll
            for (int q = 0; q < 2; ++q)
#pragma unroll
                for (int rg = 0; rg < 4; ++rg) { u32x2 w; w.x = cvtpk(cb[q][4 * rg], cb[q][4 * rg + 1]); w.y = cvtpk(cb[q][4 * rg + 2], cb[q][4 * rg + 3]);
                    *(LAS u32x2*)(lds + SL_B + (32 * lt + l31) * SSD_RS + (32 * (2 * (wave & 1) + q) + 8 * rg + 4 * hi) * 2) = w; }
            __syncthreads();
        }
        const float Dh = dskip[h];
        f32x16 Yc[2][2];
#pragma unroll
        for (int lt = 0; lt < 2; ++lt)
#pragma unroll
            for (int pt = 0; pt < 2; ++pt)
#pragma unroll
                for (int rr = 0; rr < 16; ++rr) Yc[lt][pt][rr] = 0.f;
#pragma unroll
        for (int dir = 0; dir < 2; ++dir) {
            const LAS float* cs = (const LAS float*)(lds + SL_TAB + (dir * 4 + hh) * 1024); const LAS float* dtv = cs + 128;
            {
                const float el0 = __expf(cs[64 * lh + l31]), el1 = __expf(cs[64 * lh + 32 + l31]);
#pragma unroll
                for (int ks = 0; ks < 8; ++ks) {
#pragma unroll
                    for (int lt = 0; lt < 2; ++lt) { const bf16x8 raw = frag_row(lds + SL_C, SSD_RS, 64 * lh + 32 * lt, 16 * ks, lane); const float el = lt ? el1 : el0;
                        u32x4 w; w.x = cvtpk(bfx(raw[0]) * el, bfx(raw[1]) * el); w.y = cvtpk(bfx(raw[2]) * el, bfx(raw[3]) * el); w.z = cvtpk(bfx(raw[4]) * el, bfx(raw[5]) * el); w.w = cvtpk(bfx(raw[6]) * el, bfx(raw[7]) * el);
                        const bf16x8 af = __builtin_bit_cast(bf16x8, w);
#pragma unroll
                        for (int pt = 0; pt < 2; ++pt) Yc[lt][pt] = __builtin_amdgcn_mfma_f32_32x32x16_bf16(af, pf[ks][pt], Yc[lt][pt], 0, 0, 0); }
                    __builtin_amdgcn_sched_barrier(0); }
            }
            if (dir == 0) {
                const bf16_t* pp = ST + ((((size_t)b * 32 + c) * 2 + 1) * 8 + h) * 8192;
#pragma unroll
                for (int ks = 0; ks < 8; ++ks)
#pragma unroll
                    for (int pt = 0; pt < 2; ++pt) pf[ks][pt] = *(const bf16x8*)(pp + (32 * pt + l31) * 128 + 16 * ks + 8 * h2); }
#pragma unroll 1
            for (int ks = 0; ks < 8; ++ks) {
                const bool need0 = dir ? (16 * ks + 15 >= 64 * lh) : (16 * ks <= 64 * lh + 31), need1 = dir ? (16 * ks + 15 >= 64 * lh + 32) : (16 * ks <= 64 * lh + 63);
                if (!(need0 || need1)) continue;
                bf16x8 xf[2];
#pragma unroll
                for (int pt = 0; pt < 2; ++pt) xf[pt] = frag_tr(lds + SL_X, SSD_RSX, 16 * ks, 64 * hh + 32 * pt, lane);
                const f32x4 c0 = *(const LAS f32x4*)(cs + 16 * ks + 8 * h2), c1 = *(const LAS f32x4*)(cs + 16 * ks + 8 * h2 + 4);
                const f32x4 e0 = *(const LAS f32x4*)(dtv + 16 * ks + 8 * h2), e1 = *(const LAS f32x4*)(dtv + 16 * ks + 8 * h2 + 4);
#pragma unroll
                for (int lt = 0; lt < 2; ++lt) { if (!(lt ? need1 : need0)) continue;
                    const int l = 64 * lh + 32 * lt + l31; const float csl = cs[l];
                    const bf16x8 cbv = frag_row(lds + SL_B, SSD_RS, 64 * lh + 32 * lt, 16 * ks, lane);
                    float gv[8];
#pragma unroll
                    for (int j = 0; j < 8; ++j) { const int sidx = 16 * ks + 8 * h2 + j; const float cj = j < 4 ? c0[j] : c1[j - 4], dj = j < 4 ? e0[j] : e1[j - 4];
                        const bool ok = dir ? (sidx >= l) : (sidx <= l); float gg = ok ? bfx(cbv[j]) * __expf(csl - cj) * dj : 0.f; if (dir == 0 && sidx == l) gg += Dh; gv[j] = gg; }
                    u32x4 w; w.x = cvtpk(gv[0], gv[1]); w.y = cvtpk(gv[2], gv[3]); w.z = cvtpk(gv[4], gv[5]); w.w = cvtpk(gv[6], gv[7]);
                    const bf16x8 af = __builtin_bit_cast(bf16x8, w);
#pragma unroll
                    for (int pt = 0; pt < 2; ++pt) Yc[lt][pt] = __builtin_amdgcn_mfma_f32_32x32x16_bf16(af, xf[pt], Yc[lt][pt], 0, 0, 0); }
            }
        }
        __syncthreads();
        { LAS unsigned char* yimg = lds + (64 * lh) * SSD_RSY + (64 * hh + l31) * 4;
#pragma unroll
          for (int lt = 0; lt < 2; ++lt)
#pragma unroll
              for (int pt = 0; pt < 2; ++pt)
#pragma unroll
                  for (int rr = 0; rr < 16; ++rr) *(LAS float*)(yimg + (32 * lt + crow(rr, hi)) * SSD_RSY + 32 * pt * 4) = Yc[lt][pt][rr]; }
        __syncthreads();
        {
            const f32x4 nw = *(const f32x4*)(normw + 256 * g + 4 * lane);
#pragma unroll 4
            for (int rr = 0; rr < 16; ++rr) { const int l = wave * 16 + rr; const size_t tok = (size_t)b * SEQ + 128 * c + l;
                const f32x4 y = *(const LAS f32x4*)(lds + l * SSD_RSY + 16 * lane);
                const u32x2 zw = *(const u32x2*)(PROJ + tok * PROJW + COL_Z + 256 * g + 4 * lane);
                const f32x4 z = (f32x4){bflo(zw.x), bfhi(zw.x), bflo(zw.y), bfhi(zw.y)};
                f32x4 v;
#pragma unroll
                for (int e = 0; e < 4; ++e) v[e] = y[e] * z[e] * __builtin_amdgcn_rcpf(1.0f + __expf(-z[e]));
                const float ss = wave_sum((v[0] * v[0] + v[1] * v[1]) + (v[2] * v[2] + v[3] * v[3]));
                const float r = 1.0f / sqrtf(ss * (1.0f / 256.0f) + EPS);
                u32x2 o; o.x = cvtpk(v[0] * r * nw[0], v[1] * r * nw[1]); o.y = cvtpk(v[2] * r * nw[2], v[3] * r * nw[3]);
                *(u32x2*)(MIX + tok * 1024 + 512 + 256 * g + 4 * lane) = o; }
        }
        __syncthreads();
    }
}

#define XB_TMO      128
#define XB_XCNT(j)  (256  + 64 * (j))
#define XB_XSUB(j)  (1280 + 64 * (j))
#define XB_XGEN(j)  (2304 + 64 * (j))
#define XB_TOP      3328
#define XB_TOPGEN   3392
#define XCD_BAR_WORDS 3456
#define XB_SPIN_CAP (1u << 18)
__device__ __forceinline__ unsigned xb_ld(unsigned* p)              { return __hip_atomic_load(p, __ATOMIC_RELAXED, __HIP_MEMORY_SCOPE_AGENT); }
__device__ __forceinline__ unsigned xb_add(unsigned* p, unsigned v) { return __hip_atomic_fetch_add(p, v, __ATOMIC_RELAXED, __HIP_MEMORY_SCOPE_AGENT); }
__device__ __forceinline__ unsigned xb_xcc_id() { return (unsigned)__builtin_amdgcn_s_getreg((3 << 11) | 20) & 0xFu; }
#define XB_SPIN(cond, bar) do { unsigned _sp = 0; while (cond) { __builtin_amdgcn_s_sleep(1); \
    if ((++_sp & 255u) == 0u) { if (xb_ld(&(bar)[XB_TMO])) break; if (_sp > XB_SPIN_CAP) { atomicAdd(&(bar)[XB_TMO], 1u); break; } } } } while (0)
struct XcdBarrier { unsigned* bar; unsigned x; volatile LAS unsigned* st; };
__device__ __forceinline__ XcdBarrier xcd_barrier_post(unsigned* bar, volatile LAS unsigned* st) {
    XcdBarrier b; b.bar = bar; b.x = xb_xcc_id(); b.st = st;
    if (threadIdx.x == 0) (void)xb_add(&bar[XB_XCNT(b.x)], 1u);
    return b;
}
__device__ __forceinline__ void xcd_barrier_complete(unsigned* bar, unsigned x, unsigned& nloc, unsigned& nx) {
    const unsigned G = gridDim.x * gridDim.y * gridDim.z;
    unsigned sum, cnt, mine, sp = 0u;
    for (;;) {
        sum = 0u; cnt = 0u; mine = 0u;
#pragma unroll
        for (unsigned j = 0; j < 16; ++j) { const unsigned c = xb_ld(&bar[XB_XCNT(j)]); sum += c; cnt += (c > 0u) ? 1u : 0u; mine = (j == x) ? c : mine; }
        if (sum == G) break;
        __builtin_amdgcn_s_sleep(1);
        if ((++sp & 255u) == 0u) { if (xb_ld(&bar[XB_TMO])) break; if (sp > XB_SPIN_CAP) { atomicAdd(&bar[XB_TMO], 1u); break; } }
    }
    nloc = mine > 0u ? mine : 1u; nx = cnt > 0u ? cnt : 1u;
}
__device__ __forceinline__ void xcd_barrier(const XcdBarrier& b) {
    asm volatile("s_waitcnt vmcnt(0)" ::: "memory");
    __syncthreads();
    if (threadIdx.x == 0) {
        unsigned* bar = b.bar;
        __builtin_amdgcn_s_waitcnt(0);
        unsigned nloc = b.st[0], nx = b.st[1];
        if (nloc == 0u) { xcd_barrier_complete(bar, b.x, nloc, nx); b.st[0] = nloc; b.st[1] = nx; }
        const unsigned old = xb_add(&bar[XB_XSUB(b.x)], 1u);
        const unsigned gen = old / nloc;
        if (old + 1u == (gen + 1u) * nloc) {
            __builtin_amdgcn_fence(__ATOMIC_RELEASE, "agent");
            asm volatile("s_waitcnt vmcnt(0)" ::: "memory");
            const unsigned og = xb_add(&bar[XB_TOP], 1u);
            const unsigned tg = og / nx;
            if (og + 1u == (tg + 1u) * nx) xb_add(&bar[XB_TOPGEN], 1u);
            else XB_SPIN(xb_ld(&bar[XB_TOPGEN]) == tg, bar);
            __builtin_amdgcn_fence(__ATOMIC_ACQUIRE, "agent");
            xb_add(&bar[XB_XGEN(b.x)], 1u);
            asm volatile("s_waitcnt vmcnt(0)" ::: "memory");
        } else {
            XB_SPIN(xb_ld(&bar[XB_XGEN(b.x)]) == gen, bar);
            __builtin_amdgcn_fence(__ATOMIC_ACQUIRE, "agent");
            asm volatile("s_waitcnt vmcnt(0)" ::: "memory");
        }
    }
    __syncthreads();
}

struct Args { const float* in[24]; float* out; unsigned char* ws; int ph_lo, ph_hi; };
enum { I_X = 0, I_W_IN, I_ATTN_NORM_W, I_CONV_W, I_CONV_B, I_DT_BIAS_F, I_A_LOG_F, I_DT_BIAS_B, I_A_LOG_B, I_D_SKIP, I_SSD_NORM_W,
       I_W_OUT, I_LN1_W, I_LN1_B, I_ROUTER_W, I_ROUTER_B, I_W_GATE, I_B_GATE, I_W_UP, I_B_UP, I_W_DOWN, I_B_DOWN, I_LN2_W, I_LN2_B };
#define INP(name) in_ptr(lds, I_##name)

__device__ __forceinline__ void transpose_item(const float* W, int ldw, int k0, int n0, bf16_t* WT, int dbase, int dmul, LAS float* scr, int lane) {
    float v[32];
    const float* wp = W + (size_t)(k0 + (lane >> 5)) * ldw + n0 + (lane & 31);
#pragma unroll
    for (int i = 0; i < 32; ++i) v[i] = wp[(size_t)(2 * i) * ldw];
#pragma unroll
    for (int i = 0; i < 32; ++i) scr[(2 * i + (lane >> 5)) * 33 + (lane & 31)] = v[i];
    LDS_WAIT(); asm volatile("" ::: "memory");
    const int c = lane & 7;
#pragma unroll
    for (int j = 0; j < 4; ++j) { const int n = (lane >> 3) + 8 * j; const LAS float* sp = scr + (8 * c) * 33 + n;
        u32x4 o; o.x = cvtpk(sp[0 * 33], sp[1 * 33]); o.y = cvtpk(sp[2 * 33], sp[3 * 33]); o.z = cvtpk(sp[4 * 33], sp[5 * 33]); o.w = cvtpk(sp[6 * 33], sp[7 * 33]);
        *(u32x4*)(WT + (size_t)(dbase + dmul * n) * 1024 + k0 + 8 * c) = o; }
    LDS_WAIT(); asm volatile("" ::: "memory");
}

__device__ __forceinline__ void transpose_item_f8(const float* W, int ldw, int k0, int n0, unsigned char* WT, int dbase, float sc, LAS float* scr, int lane) {
    float v[32];
    const float* wp = W + (size_t)(k0 + (lane >> 5)) * ldw + n0 + (lane & 31);
#pragma unroll
    for (int i = 0; i < 32; ++i) v[i] = wp[(size_t)(2 * i) * ldw];
#pragma unroll
    for (int i = 0; i < 32; ++i) scr[(2 * i + (lane >> 5)) * 33 + (lane & 31)] = v[i] * sc;
    LDS_WAIT(); asm volatile("" ::: "memory");
    const int c = lane & 7;
#pragma unroll
    for (int j = 0; j < 4; ++j) { const int n = (lane >> 3) + 8 * j; const LAS float* sp = scr + (8 * c) * 33 + n;
        int lo = __builtin_amdgcn_cvt_pk_fp8_f32(sp[0 * 33], sp[1 * 33], 0, false); lo = __builtin_amdgcn_cvt_pk_fp8_f32(sp[2 * 33], sp[3 * 33], lo, true);
        int hi = __builtin_amdgcn_cvt_pk_fp8_f32(sp[4 * 33], sp[5 * 33], 0, false); hi = __builtin_amdgcn_cvt_pk_fp8_f32(sp[6 * 33], sp[7 * 33], hi, true);
        *(u32x2*)(WT + (size_t)(dbase + n) * 1024 + k0 + 8 * c) = (u32x2){(unsigned)lo, (unsigned)hi}; }
    LDS_WAIT(); asm volatile("" ::: "memory");
}

__global__ void __launch_bounds__(NTHREADS, 2) hymba_fwd(Args a) {
    extern __shared__ __attribute__((aligned(16))) unsigned char lds_raw[];
    LAS unsigned char* lds = (LAS unsigned char*)lds_raw;
    const int tid0 = threadIdx.x, wave = __builtin_amdgcn_readfirstlane(tid0 >> 6);
    int tid = tid0; const int lane = tid & 63;
    const int G = gridDim.x; const int bx = blockIdx.x; const int vcu = (G % 8 == 0) ? (bx % 8) * (G / 8) + bx / 8 : bx;
    const int gw = vcu * NWAVES + wave, NGW = G * NWAVES;
    unsigned char* ws = a.ws;
    unsigned* ctl = (unsigned*)(ws + WS_CTL);
    f32x2* rope = (f32x2*)(ws + WS_ROPE);
    bf16_t* WIN = (bf16_t*)(ws + WS_WIN); bf16_t* WOUT = (bf16_t*)(ws + WS_WOUT); bf16_t* WGU = (bf16_t*)(ws + WS_WGU);
    unsigned char* WDN8 = ws + WS_WDN;
    float* TOPG = (float*)(ws + RT_TOPG);
    int* TOKV = (int*)(ws + WS_WIN); int* ROWOF = (int*)(ws + RT_YROW); int* GCNT = (int*)(ws + WS_CTL + 65536);
    float* DT = (float*)(ws + WS_DT);
    unsigned* WQ = (unsigned*)(ws + WS_CTL + 98304);
    bf16_t* XB = (bf16_t*)(ws + WS_XB); bf16_t* MIX = (bf16_t*)a.out;     bf16_t* H1 = (bf16_t*)(ws + WS_H1);
    bf16_t* PROJ = (bf16_t*)(ws + WS_PROJ); bf16_t* XBC2 = (bf16_t*)(ws + WS_XBC2); bf16_t* ATTO = (bf16_t*)(ws + WS_ATTO);
    unsigned char* ACT8 = ws + WS_ACT; unsigned char* Y8 = ws + WS_Y;
    float* ML = (float*)(ws + WS_ML); unsigned char* H1F8 = ws + WS_H1F8; unsigned char* WGU8 = ws + WS_WGU;
    bf16_t* ST = (bf16_t*)((unsigned char*)a.out + 64 * MiB); float* CD = (float*)(ws + RT_CD);
    float* YD = a.out;
    bf16_t* PRE1 = (bf16_t*)((unsigned char*)a.out + 64 * MiB);

    for (int u = tid; u < (LDS_BYTES - LDS_MISC) / 4; u += NTHREADS) ((LAS unsigned*)(lds + LDS_MISC))[u] = 0u;
    if (tid < 24) ((LAS unsigned long long*)(lds + LM_PTRS))[tid] = (unsigned long long)a.in[tid];
    __syncthreads();
    XcdBarrier bar = xcd_barrier_post(ctl + CW_BAR, (volatile LAS unsigned*)(lds + LM_BAR));
#define IN(k) true
#define SEAM(k) do { if (IN(k) && IN((k) + 1)) xcd_barrier(bar); } while (0)
#ifndef RPMASK
#define RPMASK 0
#endif
#define REP(k) for (int _r = 0; _r < ((((RPMASK) >> (k)) & 1) ? 2 : 1); ++_r)

    constexpr int NEI = 3 * NE * 512;
    unsigned* QW = WQ + 192;
    auto expert_item = [&](int r) {
        int ln = threadIdx.x; asm volatile("" : "+v"(ln)); ln &= 63;
        LAS float* scr = (LAS float*)(lds + wave * 16384);
        const int which = r / (NE * 512); r -= which * (NE * 512); const int e = r >> 9, q = r & 511, kb = q >> 5, n0 = 32 * (q & 31);
        if (which == 2) transpose_item_f8(INP(W_DOWN) + (size_t)e * 1024 * 1024, 1024, 64 * kb, n0, WDN8 + (size_t)e * 1024 * 1024, n0, F8_SCALE_D, scr, ln);
        else transpose_item_f8((which ? INP(W_UP) : INP(W_GATE)) + (size_t)e * 1024 * 1024, 1024, 64 * kb, n0, WGU8 + (size_t)e * 2048 * 1024, (n0 >> 7) * 256 + which * 128 + (n0 & 127), F8_SCALE_W, scr, ln);
    };
    auto steal_wait = [&]() {
        volatile LAS int* sw = (volatile LAS int*)(lds + LM_STEAL);
        asm volatile("s_waitcnt vmcnt(0)" ::: "memory");
        __syncthreads();
        unsigned gen = 0u, tg = 0u; int role = 0;
        unsigned* bw = bar.bar;
        if (threadIdx.x == 0) {
            __builtin_amdgcn_s_waitcnt(0);
            unsigned nloc = bar.st[0], nx = bar.st[1];
            if (nloc == 0u) { xcd_barrier_complete(bw, bar.x, nloc, nx); bar.st[0] = nloc; bar.st[1] = nx; }
            const unsigned old = xb_add(&bw[XB_XSUB(bar.x)], 1u);
            gen = old / nloc;
            if (old + 1u == (gen + 1u) * nloc) {
                __builtin_amdgcn_fence(__ATOMIC_RELEASE, "agent");
                asm volatile("s_waitcnt vmcnt(0)" ::: "memory");
                const unsigned og = xb_add(&bw[XB_TOP], 1u);
                tg = og / nx; role = 1;
                if (og + 1u == (tg + 1u) * nx) { xb_add(&bw[XB_TOPGEN], 1u); role = 2; }
            }
        }
        for (unsigned sp = 0u; ; ++sp) {
            if (threadIdx.x == 0) {
                bool open = role == 2 ? true : (role == 1 ? xb_ld(&bw[XB_TOPGEN]) != tg : xb_ld(&bw[XB_XGEN(bar.x)]) != gen);
                if (!open && (sp & 63u) == 63u) { if (xb_ld(&bw[XB_TMO])) open = true; else if (sp > XB_SPIN_CAP) { atomicAdd(&bw[XB_TMO], 1u); open = true; } }
                int base = NEI;
                if (open) { __builtin_amdgcn_fence(__ATOMIC_ACQUIRE, "agent"); if (role != 0) xb_add(&bw[XB_XGEN(bar.x)], 1u); asm volatile("s_waitcnt vmcnt(0)" ::: "memory"); }
                else if (sw[2] == 0) { base = (int)xb_add(QW, 8u); if (base >= NEI) { base = NEI; sw[2] = 1; } }
                sw[0] = open ? 1 : 0; sw[1] = base;
            }
            __syncthreads();
            const int open = sw[0], base = sw[1];
            if (open) break;
            if (base < NEI) expert_item(base + wave); else __builtin_amdgcn_s_sleep(4);
            __syncthreads();
        }
        __syncthreads();
    };
    auto steal_drain = [&]() {
        volatile LAS int* sw = (volatile LAS int*)(lds + LM_STEAL);
        for (;;) { __syncthreads(); if (threadIdx.x == 0) sw[1] = (int)xb_add(QW, 8u); __syncthreads(); const int base = sw[1]; if (base >= NEI) break; expert_item(base + wave); }
        xcd_barrier(bar);
    };

    REP(0) if (IN(0)) {
        int tid = threadIdx.x; asm volatile("" : "+v"(tid)); tid &= 511; const int lane = tid & 63; (void)lane;
        for (int i = gw * 64 + lane; i < SEQ * 32; i += NGW * 64) { const int pos = i >> 5, j = i & 31;
            const float inv = powf(10000.0f, -(float)j / 32.0f); const float ang = (float)pos * inv; float s, c; sincosf(ang, &s, &c); rope[i] = (f32x2){c, s}; }
        LAS float* scr = (LAS float*)(lds + wave * 16384);
        constexpr int I_IN = 16 * 96, I_OUT = 16 * 32;
        constexpr int NITEMS = I_IN + I_OUT;
        for (int it = gw; it < NITEMS; it += NGW) {
            int r = it;
            if (r < I_IN) { const int kb = r / 96, nb = r % 96, n0 = 32 * nb;
                if (n0 < 1024) transpose_item(INP(W_IN), WIN_LD, 64 * kb, n0, WIN, (n0 & ~63) + ((n0 >> 5) & 1), 2, scr, lane);
                else transpose_item(INP(W_IN), WIN_LD, 64 * kb, n0, WIN, n0, 1, scr, lane);
                continue; } r -= I_IN;
            transpose_item(INP(W_OUT), 1024, 64 * (r / 32), 32 * (r % 32), WOUT, 32 * (r % 32), 1, scr, lane);
        }
        __syncthreads();
        LAS float* wdt = (LAS float*)lds;
        { const float* wi = INP(W_IN);
#pragma unroll 1
          for (int b0 = 0; b0 < 32; b0 += 16) { float t[16];
#pragma unroll
              for (int u = 0; u < 16; ++u) { const int i = tid + (b0 + u) * NTHREADS; t[u] = wi[(size_t)(i >> 4) * WIN_LD + 3072 + (i & 15)]; }
#pragma unroll
              for (int u = 0; u < 16; ++u) { const int i = tid + (b0 + u) * NTHREADS; wdt[(i & 15) * 1024 + (i >> 4)] = t[u]; } } }
        __syncthreads();
        {
            const float* X = INP(X);
            f32x4 v[2][4], vn[2][4];
            int row = gw;
#pragma unroll
            for (int q = 0; q < 2; ++q)
#pragma unroll
                for (int j = 0; j < 4; ++j) v[q][j] = ((const f32x4*)(X + (size_t)(row + q * NGW) * DM) + lane)[64 * j];
            for (; row < NTOK; row += 2 * NGW) {
                const int nrow = row + 2 * NGW;
                if (nrow < NTOK) {
#pragma unroll
                    for (int q = 0; q < 2; ++q)
#pragma unroll
                        for (int j = 0; j < 4; ++j) vn[q][j] = ((const f32x4*)(X + (size_t)(nrow + q * NGW) * DM) + lane)[64 * j]; }
#pragma unroll
                for (int q = 0; q < 2; ++q) { u32x2* o8 = (u32x2*)(XB + (size_t)(row + q * NGW) * DM) + lane;
#pragma unroll
                    for (int j = 0; j < 4; ++j) { u32x2 w; w.x = cvtpk(v[q][j][0], v[q][j][1]); w.y = cvtpk(v[q][j][2], v[q][j][3]); o8[64 * j] = w; } }
#pragma unroll 1
                for (int cg = 0; cg < 4; ++cg) {
                    float sacc[8];
#pragma unroll
                    for (int ci = 0; ci < 4; ++ci) { f32x2 s2 = (f32x2){0.f, 0.f};
#pragma unroll
                        for (int j = 0; j < 4; ++j) { const f32x4 w = *(const LAS f32x4*)(wdt + (4 * cg + ci) * 1024 + 256 * j + 4 * lane);
#pragma unroll
                            for (int e = 0; e < 4; ++e) s2 = __builtin_elementwise_fma((f32x2){v[0][j][e], v[1][j][e]}, (f32x2){w[e], w[e]}, s2); }
                        sacc[ci] = s2[0]; sacc[4 + ci] = s2[1]; }
                    bfly_reduce<8>(sacc, lane);
                    if ((lane & 7) == 0) DT[(size_t)(row + (lane >> 5) * NGW) * 16 + 4 * cg + ((lane >> 3) & 3)] = sacc[0];
                }
#pragma unroll
                for (int q = 0; q < 2; ++q)
#pragma unroll
                    for (int j = 0; j < 4; ++j) v[q][j] = vn[q][j];
            }
        }
    }
    SEAM(0);

    REP(1) if (IN(1)) {
        int tid = threadIdx.x; asm volatile("" : "+v"(tid)); tid &= 511; const int lane = tid & 63; (void)lane;
        pg8::StaticOrder S; S.init(NTOK, PROJW, G, bx, WIN); pg8::IdentityRows RM; pg8::EpiProj E{PROJ, rope};
        pg8::gemm_phase(lds, XB, S, RM, E);
    }
    steal_wait();

    REP(2) if (IN(2)) {
        int tid = threadIdx.x; asm volatile("" : "+v"(tid)); tid &= 511; const int lane = tid & 63; (void)lane;
        REP(14) {
            const float* cwp = INP(CONV_W); const float* cbp = INP(CONV_B);
            for (int item = gw; item < (NTOK / 16) * 2; item += NGW) {
                const int half = item & 1, run = item >> 1, c8 = half * 512 + lane * 8, tok0 = run * 16, pos0 = tok0 & (SEQ - 1);
                f32x4 wv[5][2], bv[2];
#pragma unroll
                for (int j = 0; j < 5; ++j) { wv[j][0] = *(const f32x4*)(cwp + j * 1024 + c8); wv[j][1] = *(const f32x4*)(cwp + j * 1024 + c8 + 4); }
                bv[0] = *(const f32x4*)(cbp + c8); bv[1] = *(const f32x4*)(cbp + c8 + 4);
                u32x4 rows[20];
#pragma unroll
                for (int t = 0; t < 20; ++t) { const int p = pos0 + t - 2;
                    rows[t] = (p >= 0 && p < SEQ) ? *(const u32x4*)(PROJ + (size_t)(tok0 + t - 2) * PROJW + COL_X + c8) : (u32x4){0u, 0u, 0u, 0u}; }
#pragma unroll
                for (int t = 0; t < 16; ++t) { f32x4 a0 = bv[0], a1 = bv[1];
#pragma unroll
                    for (int j = 0; j < 5; ++j) { const u32x4 w = rows[t + j];
                        a0 += (f32x4){bflo(w.x), bfhi(w.x), bflo(w.y), bfhi(w.y)} * wv[j][0]; a1 += (f32x4){bflo(w.z), bfhi(w.z), bflo(w.w), bfhi(w.w)} * wv[j][1]; }
#pragma unroll
                    for (int e = 0; e < 4; ++e) { a0[e] = a0[e] * __builtin_amdgcn_rcpf(1.0f + __expf(-a0[e])); a1[e] = a1[e] * __builtin_amdgcn_rcpf(1.0f + __expf(-a1[e])); }
                    u32x4 o; o.x = cvtpk(a0[0], a0[1]); o.y = cvtpk(a0[2], a0[3]); o.z = cvtpk(a1[0], a1[1]); o.w = cvtpk(a1[2], a1[3]);
                    *(u32x4*)(XBC2 + (size_t)(tok0 + t) * 1024 + c8) = o; __builtin_amdgcn_sched_barrier(0); }
            }
        }
        REP(13) attn_pass<1, true>(PROJ, ATTO, ML, lds, vcu, G, wave, lane);
    }
    steal_wait();

    if (IN(3)) {
        int tid = threadIdx.x; asm volatile("" : "+v"(tid)); tid &= 511; const int lane = tid & 63; (void)lane;
        REP(3) ssd_pass_a(XBC2, DT, ST, CD, INP(A_LOG_F), INP(A_LOG_B), INP(DT_BIAS_F), INP(DT_BIAS_B), lds, vcu, G, tid, wave, lane);
        attn_pass<4, false>(PROJ, ATTO, ML, lds, vcu, G, wave, lane);
    }
    steal_wait();

    if (IN(4)) {
        int tid = threadIdx.x; asm volatile("" : "+v"(tid)); tid &= 511; const int lane = tid & 63; (void)lane; ssd_pass_b(ST, CD, gw * 64 + lane, NGW * 64); attn_pass<16, false>(PROJ, ATTO, ML, lds, vcu, G, wave, lane); }
    steal_wait();

    REP(5) if (IN(5)) { int tid = threadIdx.x; asm volatile("" : "+v"(tid)); tid &= 511; const int lane = tid & 63;
        ssd_pass_c(XBC2, DT, ST, PROJ, MIX, INP(A_LOG_F), INP(A_LOG_B), INP(DT_BIAS_F), INP(DT_BIAS_B), INP(D_SKIP), INP(SSD_NORM_W), lds, vcu, G, tid, wave, lane);
        const float* nwp = INP(ATTN_NORM_W) + 8 * lane; const f32x4 nw0 = *(const f32x4*)nwp, nw1 = *(const f32x4*)(nwp + 4);
        for (int tok0 = gw; tok0 < NTOK; tok0 += 4 * NGW) {
            u32x4 wv[4];
#pragma unroll
            for (int q = 0; q < 4; ++q) { const int tok = tok0 + q * NGW; wv[q] = tok < NTOK ? *(const u32x4*)(ATTO + (size_t)tok * 512 + 8 * lane) : (u32x4){0u, 0u, 0u, 0u}; }
#pragma unroll
            for (int q = 0; q < 4; ++q) { const int tok = tok0 + q * NGW; const u32x4 w = wv[q];
                float v[8] = {bflo(w.x), bfhi(w.x), bflo(w.y), bfhi(w.y), bflo(w.z), bfhi(w.z), bflo(w.w), bfhi(w.w)};
                float ss = 0.f;
#pragma unroll
                for (int e = 0; e < 8; ++e) ss += v[e] * v[e];
                ss = wave_sum(ss); const float r = 1.0f / sqrtf(ss * (1.0f / 512.0f) + EPS);
                u32x4 o; o.x = cvtpk(v[0] * r * nw0[0], v[1] * r * nw0[1]); o.y = cvtpk(v[2] * r * nw0[2], v[3] * r * nw0[3]); o.z = cvtpk(v[4] * r * nw1[0], v[5] * r * nw1[1]); o.w = cvtpk(v[6] * r * nw1[2], v[7] * r * nw1[3]);
                if (tok < NTOK) *(u32x4*)(MIX + (size_t)tok * 1024 + 8 * lane) = o; }
        }
    }
    steal_wait();

    REP(7) if (IN(7)) {
        int tid = threadIdx.x; asm volatile("" : "+v"(tid)); tid &= 511; const int lane = tid & 63; (void)lane;
        pg8::StaticOrder S; S.init(NTOK, DM, G, bx, WOUT); pg8::IdentityRows RM; pg8::EpiOut E{XB, PRE1};
        pg8::gemm_phase(lds, MIX, S, RM, E);
    }
    steal_wait();

    REP(8) if (IN(8)) {
        int tid = threadIdx.x; asm volatile("" : "+v"(tid)); tid &= 511; const int lane = tid & 63; (void)lane;
        LAS float* rwT = (LAS float*)lds;
        { const float* rw = INP(ROUTER_W);
#pragma unroll 1
          for (int b0 = 0; b0 < 64; b0 += 16) { float t[16];
#pragma unroll
              for (int u = 0; u < 16; ++u) t[u] = rw[tid + (b0 + u) * NTHREADS];
#pragma unroll
              for (int u = 0; u < 16; ++u) { const int i = tid + (b0 + u) * NTHREADS; rwT[(i & 31) * 1028 + (i >> 5)] = t[u]; } } }
        LAS int* hist = (LAS int*)(lds + LM_HIST); LAS int* base = (LAS int*)(lds + LM_BASE); LAS int* pick = (LAS int*)(lds + LM_PICK);
        LAS float* lgs = (LAS float*)(lds + 131584) + wave * 128;
        f32x4 lw[4], lb[4];
#pragma unroll
        for (int j = 0; j < 4; ++j) { lw[j] = ((const f32x4*)INP(LN1_W))[64 * j + lane]; lb[j] = ((const f32x4*)INP(LN1_B))[64 * j + lane]; }
        const float rbias0 = INP(ROUTER_B)[lane & 15], rbias1 = INP(ROUTER_B)[16 + (lane & 15)];
        for (int vb = bx; vb < 256; vb += G) {
            if (tid < 32) hist[tid] = 0;
            __syncthreads();
            const int tokw = vb * 128 + wave * 16;
            f32x4 v[4][4]; u32x2 vn[4][4];
#pragma unroll
            for (int q = 0; q < 4; ++q)
#pragma unroll
                for (int j = 0; j < 4; ++j) { const u32x2 w = ((const u32x2*)(PRE1 + (size_t)(tokw + q) * DM) + lane)[64 * j]; v[q][j] = (f32x4){bflo(w.x), bfhi(w.x), bflo(w.y), bfhi(w.y)}; }
#pragma unroll 1
            for (int qi = 0; qi < 4; ++qi) {
                const int tok0 = tokw + 4 * qi;
                if (qi < 3) {
#pragma unroll
                    for (int q = 0; q < 4; ++q)
#pragma unroll
                        for (int j = 0; j < 4; ++j) vn[q][j] = ((const u32x2*)(PRE1 + (size_t)(tok0 + 4 + q) * DM) + lane)[64 * j]; }
#pragma unroll
                for (int q = 0; q < 4; ++q) { float s = 0.f;
#pragma unroll
                    for (int j = 0; j < 4; ++j) s += (v[q][j][0] + v[q][j][1]) + (v[q][j][2] + v[q][j][3]);
                    const float mean = wave_sum(s) * (1.0f / DM); float s2 = 0.f;
#pragma unroll
                    for (int j = 0; j < 4; ++j) { v[q][j] = v[q][j] - mean; s2 += (v[q][j][0] * v[q][j][0] + v[q][j][1] * v[q][j][1]) + (v[q][j][2] * v[q][j][2] + v[q][j][3] * v[q][j][3]); }
                    const float rstd = 1.0f / sqrtf(wave_sum(s2) * (1.0f / DM) + EPS);
                    u32x2* o8 = (u32x2*)(H1 + (size_t)(tok0 + q) * DM) + lane;
#pragma unroll
                    for (int j = 0; j < 4; ++j) { v[q][j] = v[q][j] * rstd * lw[j] + lb[j]; u32x2 w; w.x = cvtpk(v[q][j][0], v[q][j][1]); w.y = cvtpk(v[q][j][2], v[q][j][3]); o8[64 * j] = w;
                        int p8 = __builtin_amdgcn_cvt_pk_fp8_f32(v[q][j][0] * F8_SCALE_H, v[q][j][1] * F8_SCALE_H, 0, false); p8 = __builtin_amdgcn_cvt_pk_fp8_f32(v[q][j][2] * F8_SCALE_H, v[q][j][3] * F8_SCALE_H, p8, true);
                        ((int*)(H1F8 + (size_t)(tok0 + q) * DM))[64 * j + lane] = p8; } }
                f32x2 hp[2][4][4];
#pragma unroll
                for (int j = 0; j < 4; ++j)
#pragma unroll
                    for (int e = 0; e < 4; ++e) { hp[0][j][e] = (f32x2){v[0][j][e], v[1][j][e]}; hp[1][j][e] = (f32x2){v[2][j][e], v[3][j][e]}; }
#pragma unroll 1
                for (int eg = 0; eg < 8; ++eg) {
                    float sacc[16];
#pragma unroll
                    for (int ei = 0; ei < 4; ++ei) { f32x2 sa = (f32x2){0.f, 0.f}, sb = (f32x2){0.f, 0.f};
#pragma unroll
                        for (int j = 0; j < 4; ++j) { const f32x4 w = *(const LAS f32x4*)(rwT + (4 * eg + ei) * 1028 + 256 * j + 4 * lane);
#pragma unroll
                            for (int e = 0; e < 4; ++e) { const f32x2 ww = (f32x2){w[e], w[e]}; sa = __builtin_elementwise_fma(hp[0][j][e], ww, sa); sb = __builtin_elementwise_fma(hp[1][j][e], ww, sb); } }
                        sacc[ei] = sa[0]; sacc[4 + ei] = sa[1]; sacc[8 + ei] = sb[0]; sacc[12 + ei] = sb[1]; }
                    bfly_reduce<16>(sacc, lane);
                    if ((lane & 3) == 0) lgs[(lane >> 4) * 32 + 4 * eg + ((lane >> 2) & 3)] = sacc[0];
                }
                const int e0 = lane & 15;
                float l0 = lgs[(lane >> 4) * 32 + e0] + rbias0, l1 = lgs[(lane >> 4) * 32 + 16 + e0] + rbias1;
                int sel[4]; float sv[4];
#pragma unroll
                for (int r = 0; r < 4; ++r) { float bv = l0; int bi = e0; if (l1 > l0) { bv = l1; bi = 16 + e0; }
#define TOPK_STEP(M) { const float ov = lane_xor_f<M>(bv, lane); const int oi = lane_xor_i<M>(bi, lane); if (ov > bv || (ov == bv && oi < bi)) { bv = ov; bi = oi; } }
                    TOPK_STEP(1) TOPK_STEP(2) TOPK_STEP(4) TOPK_STEP(8)
#undef TOPK_STEP
                    sel[r] = bi; sv[r] = bv; if (bi == e0) l0 = -INFINITY; if (bi == 16 + e0) l1 = -INFINITY; }
                const float e1 = __expf(sv[1] - sv[0]), e2 = __expf(sv[2] - sv[0]), e3 = __expf(sv[3] - sv[0]); const float inv = 1.0f / (1.0f + e1 + e2 + e3);
                if ((lane & 15) == 0) { const int tok = tok0 + (lane >> 4);
                    *(f32x4*)(TOPG + (size_t)tok * 4) = (f32x4){inv, e1 * inv, e2 * inv, e3 * inv};
#pragma unroll
                    for (int r = 0; r < 4; ++r) { const int rank = __hip_atomic_fetch_add(hist + sel[r], 1, __ATOMIC_RELAXED, __HIP_MEMORY_SCOPE_WORKGROUP); pick[(tok - vb * 128) * 4 + r] = sel[r] | (rank << 8); } }
#pragma unroll
                for (int q = 0; q < 4; ++q)
#pragma unroll
                    for (int j = 0; j < 4; ++j) { const u32x2 w = vn[q][j]; v[q][j] = (f32x4){bflo(w.x), bfhi(w.x), bflo(w.y), bfhi(w.y)}; }
            }
            __syncthreads();
            if (tid < 32) base[tid] = __hip_atomic_fetch_add(GCNT + tid, hist[tid], __ATOMIC_RELAXED, __HIP_MEMORY_SCOPE_AGENT);
            __syncthreads();
            { const int p = pick[tid], e = p & 255, slot = base[e] + (p >> 8), tok = vb * 128 + (tid >> 2);
              TOKV[e * NTOK + slot] = tok; ROWOF[tok * 4 + (tid & 3)] = (e << 20) | slot; }
            __syncthreads();
        }
    }
    steal_drain();


    REP(10) if (IN(10)) {
        int tid = threadIdx.x; asm volatile("" : "+v"(tid)); tid &= 511; const int lane = tid & 63; (void)lane;
        LAS int* segt = (LAS int*)(lds + LM_SEGT); LAS int* segc = (LAS int*)(lds + LM_SEGC);
        if (tid < 64) { const int c = tid < 32 ? __hip_atomic_load(GCNT + (tid & 31), __ATOMIC_RELAXED, __HIP_MEMORY_SCOPE_AGENT) : 0; int t = (c + 255) >> 8;
#pragma unroll
            for (int d = 1; d < 32; d <<= 1) { const int o = __shfl_up(t, d, 64); if ((tid & 63) >= d) t += o; }
            if (tid < 32) { segc[tid] = c; segt[tid + 1] = t; } if (tid == 0) segt[0] = 0; }
        __syncthreads();
        pg8::GroupedOrder S{0, segt[32], 8, G, vcu, 0, segt, segc, (const char*)WGU8, (size_t)2048 * 1024, 1024, 0};
        pg8::TableRows RM{TOKV}; pg8::EpiAct E{ACT8, INP(B_GATE), INP(B_UP), 1.0f / (F8_SCALE_H * F8_SCALE_W)};
        pg8::gemm_phase<true>(lds, H1F8, S, RM, E);
    }
    SEAM(10);

    REP(11) if (IN(11)) {
        int tid = threadIdx.x; asm volatile("" : "+v"(tid)); tid &= 511; const int lane = tid & 63; (void)lane;
        LAS int* segt = (LAS int*)(lds + LM_SEGT); LAS int* segc = (LAS int*)(lds + LM_SEGC);
        if (tid < 64) { const int c = tid < 32 ? __hip_atomic_load(GCNT + (tid & 31), __ATOMIC_RELAXED, __HIP_MEMORY_SCOPE_AGENT) : 0; int t = (c + 255) >> 8;
#pragma unroll
            for (int d = 1; d < 32; d <<= 1) { const int o = __shfl_up(t, d, 64); if ((tid & 63) >= d) t += o; }
            if (tid < 32) { segc[tid] = c; segt[tid + 1] = t; } if (tid == 0) segt[0] = 0; }
        __syncthreads();
        pg8::GroupedOrder S{0, segt[32], 4, G, vcu, 0, segt, segc, (const char*)WDN8, (size_t)1024 * 1024, 1024, 0};
        pg8::IdentityRows RM; pg8::EpiY E{Y8, INP(B_DOWN), 1.0f / (F8_SCALE_A * F8_SCALE_D)};
        pg8::gemm_phase<true>(lds, ACT8, S, RM, E);
    }
    SEAM(11);

    REP(12) if (IN(12)) {
        int tid = threadIdx.x; asm volatile("" : "+v"(tid)); tid &= 511; const int lane = tid & 63; (void)lane;
        LAS int* segt = (LAS int*)(lds + LM_SEGT); LAS int* segc = (LAS int*)(lds + LM_SEGC);
        if (tid < 64) { const int c = tid < 32 ? __hip_atomic_load(GCNT + (tid & 31), __ATOMIC_RELAXED, __HIP_MEMORY_SCOPE_AGENT) : 0; int t = (c + 255) >> 8;
#pragma unroll
            for (int d = 1; d < 32; d <<= 1) { const int o = __shfl_up(t, d, 64); if ((tid & 63) >= d) t += o; }
            if (tid < 32) { segc[tid] = c; segt[tid + 1] = t; } if (tid == 0) segt[0] = 0; }
        __syncthreads();
        f32x4 lw[4], lb[4];
#pragma unroll
        for (int j = 0; j < 4; ++j) { lw[j] = ((const f32x4*)INP(LN2_W))[64 * j + lane]; lb[j] = ((const f32x4*)INP(LN2_B))[64 * j + lane]; }
#define YROW(w) (segt[(w) >> 20] * 256 + ((w) & 0xFFFFF))
        int tok = gw; int4 rws = make_int4(0, 0, 0, 0); f32x4 gts = (f32x4){0.f, 0.f, 0.f, 0.f};
        if (tok < NTOK) { rws = *(const int4*)(ROWOF + (size_t)tok * 4); gts = *(const f32x4*)(TOPG + (size_t)tok * 4); }
        u32x2 hw[4]; unsigned yw[4][4];
        if (tok < NTOK) { const u32x2* hp = (const u32x2*)(H1 + (size_t)tok * DM) + lane; const int rwa[4] = {YROW(rws.x), YROW(rws.y), YROW(rws.z), YROW(rws.w)};
#pragma unroll
            for (int j = 0; j < 4; ++j) hw[j] = hp[64 * j];
#pragma unroll
            for (int k = 0; k < 4; ++k) { const unsigned* yp = (const unsigned*)(Y8 + (size_t)rwa[k] * 1024) + lane;
#pragma unroll
                for (int j = 0; j < 4; ++j) yw[k][j] = yp[64 * j]; } }
        for (; tok < NTOK; tok += NGW) {
            const int ntok = tok + NGW; int4 nrws = rws; f32x4 ngts = gts;
            if (ntok < NTOK) { nrws = *(const int4*)(ROWOF + (size_t)ntok * 4); ngts = *(const f32x4*)(TOPG + (size_t)ntok * 4); }
            f32x4 v[4];
#pragma unroll
            for (int j = 0; j < 4; ++j) v[j] = (f32x4){bflo(hw[j].x), bfhi(hw[j].x), bflo(hw[j].y), bfhi(hw[j].y)} * ALPHA;
#pragma unroll
            for (int k = 0; k < 4; ++k) { const float gk = gts[k] * (1.0f / F8_SCALE_Y);
#pragma unroll
                for (int j = 0; j < 4; ++j) { const unsigned w = yw[k][j]; const f32x2 lo2 = __builtin_amdgcn_cvt_pk_f32_fp8(w, false), hi2 = __builtin_amdgcn_cvt_pk_f32_fp8(w, true);
                    v[j] = v[j] + (f32x4){lo2[0], lo2[1], hi2[0], hi2[1]} * gk; } }
            if (ntok < NTOK) { const u32x2* hp = (const u32x2*)(H1 + (size_t)ntok * DM) + lane; const int rwa[4] = {YROW(nrws.x), YROW(nrws.y), YROW(nrws.z), YROW(nrws.w)};
#pragma unroll
                for (int j = 0; j < 4; ++j) hw[j] = hp[64 * j];
#pragma unroll
                for (int k = 0; k < 4; ++k) { const unsigned* yp = (const unsigned*)(Y8 + (size_t)rwa[k] * 1024) + lane;
#pragma unroll
                    for (int j = 0; j < 4; ++j) yw[k][j] = yp[64 * j]; } }
            float sm = 0.f;
#pragma unroll
            for (int j = 0; j < 4; ++j) sm += (v[j][0] + v[j][1]) + (v[j][2] + v[j][3]);
            const float mean = wave_sum(sm) * (1.0f / DM); float s2 = 0.f;
#pragma unroll
            for (int j = 0; j < 4; ++j) { v[j] = v[j] - mean; s2 += (v[j][0] * v[j][0] + v[j][1] * v[j][1]) + (v[j][2] * v[j][2] + v[j][3] * v[j][3]); }
            const float rstd = 1.0f / sqrtf(wave_sum(s2) * (1.0f / DM) + EPS);
            f32x4* op = (f32x4*)(a.out + (size_t)tok * DM) + lane;
#pragma unroll
            for (int j = 0; j < 4; ++j) op[64 * j] = v[j] * rstd * lw[j] + lb[j];
            rws = nrws; gts = ngts;
        }
    }
#undef IN
#undef SEAM
}

constexpr int N_PHASES = 13;
extern "C" void kernel_launch(void* const* d_in, const int* in_sizes, int n_in, void* d_out, int out_size, void* d_ws, size_t ws_size, hipStream_t stream) {
    static int grid = 0;
    if (grid == 0) {
        if (n_in != 24 || out_size != NTOK * DM || ws_size < WS_END) { fprintf(stderr, "kernel_launch: unexpected shapes (n_in %d out %d ws %zu)\n", n_in, out_size, ws_size); grid = -1; return; }
        int dev = 0, cus = 0, per_cu = 0;
        if (hipGetDevice(&dev) != hipSuccess || hipDeviceGetAttribute(&cus, hipDeviceAttributeMultiprocessorCount, dev) != hipSuccess) { grid = -1; return; }
        if (hipFuncSetAttribute((const void*)hymba_fwd, hipFuncAttributeMaxDynamicSharedMemorySize, LDS_BYTES) != hipSuccess) { fprintf(stderr, "kernel_launch: hipFuncSetAttribute failed\n"); grid = -1; return; }
        if (hipOccupancyMaxActiveBlocksPerMultiprocessor(&per_cu, (const void*)hymba_fwd, NTHREADS, LDS_BYTES) != hipSuccess || per_cu < 1) { fprintf(stderr, "kernel_launch: occupancy query says %d\n", per_cu); }
        (void)hipGetLastError();
        grid = cus;
    }
    if (grid < 0) return;
    (void)hipMemsetAsync((char*)d_ws + WS_CTL, 0, CTL_ZERO_BYTES, stream);
    Args a{};
    for (int i = 0; i < 24; ++i) a.in[i] = (const float*)d_in[i];
    a.out = (float*)d_out; a.ws = (unsigned char*)d_ws; a.ph_lo = 0; a.ph_hi = N_PHASES;
    hipLaunchKernelGGL(hymba_fwd, dim3(grid), dim3(NTHREADS), LDS_BYTES, stream, a);
}
```

```cpp
#include <hip/hip_runtime.h>
#include <cstdio>
#include <cstdint>
#include <cmath>

#define LAS __attribute__((address_space(3)))
#define GAS __attribute__((address_space(1)))
typedef unsigned short bf16_t;
typedef short bf16x8 __attribute__((ext_vector_type(8)));
typedef float f32x4 __attribute__((ext_vector_type(4)));
typedef float f32x2 __attribute__((ext_vector_type(2)));
typedef unsigned u32x4 __attribute__((ext_vector_type(4)));
typedef unsigned u32x2 __attribute__((ext_vector_type(2)));

constexpr int BATCH = 8, SEQ = 4096, DM = 1024, NTOK = BATCH * SEQ;
constexpr int NH = 8, HD = 64;
constexpr int PROJW = 3072;
constexpr int COL_Q = 0, COL_K = 512, COL_V = 1024, COL_Z = 1536, COL_X = 2048;
constexpr int WIN_LD = 3088;
constexpr int NE = 32, TOPK = 4;
constexpr int MAXROWS = 139264;
constexpr float ALPHA = 1.18920711500272f;
constexpr float EPS = 1e-5f;
constexpr float F8_SCALE_M = 16.0f, F8_SCALE_H = 4.0f, F8_SCALE_W = 64.0f, F8_SCALE_A = 4.0f, F8_SCALE_D = 128.0f, F8_SCALE_Y = 16.0f;
constexpr int NWAVES = 8, NTHREADS = 512;

constexpr size_t MiB = 1u << 20;
constexpr size_t WS_CTL = 0, CTL_ZERO_BYTES = 1 * MiB;
constexpr size_t WS_ROPE = 1 * MiB;
constexpr size_t WS_WIN = 2 * MiB;
constexpr size_t WS_WOUT = 8 * MiB;
constexpr size_t WS_ROUTE = 10 * MiB;
constexpr size_t RT_TOPI = WS_ROUTE, RT_TOPG = WS_ROUTE + 512 * 1024, RT_BCNT = WS_ROUTE + 1024 * 1024, RT_SEGT = WS_ROUTE + 1056 * 1024;
constexpr size_t RT_TOKR = WS_ROUTE + 1088 * 1024, RT_GATR = RT_TOKR + 576 * 1024, RT_YROW = RT_GATR + 576 * 1024;
constexpr size_t RT_CD = WS_ROUTE + 4096 * 1024;
constexpr size_t WS_DT = 16 * MiB;
constexpr size_t WS_WGU = 18 * MiB;
constexpr size_t WS_XB = 82 * MiB;
constexpr size_t WS_H1F8 = 82 * MiB;
constexpr size_t WS_PROJ = 146 * MiB;
constexpr size_t WS_H1 = 290 * MiB;
constexpr size_t WS_XBC2 = 338 * MiB;
constexpr size_t WS_ATTO = 402 * MiB;
constexpr size_t WS_ML = 434 * MiB;
constexpr size_t WS_ACT = 354 * MiB;
constexpr size_t WS_Y = 18 * MiB;
constexpr size_t WS_WDN = 490 * MiB;
constexpr size_t WS_END = 522 * MiB;
static_assert(WS_Y + (size_t)MAXROWS * 2048 <= WS_H1 && WS_ACT + (size_t)MAXROWS * 1024 <= WS_WDN && WS_H1 + (size_t)NTOK * 2048 <= WS_ACT, "workspace map");
constexpr int CW_BAR = 4096;

constexpr int RING_BYTES = 131072;
constexpr int LDS_MISC = 155648;
constexpr int LDS_BYTES = 163840;
constexpr int LM_BAR = LDS_MISC + 0;
constexpr int LM_STEAL = LDS_MISC + 64;
constexpr int LM_HIST = LDS_MISC + 256;
constexpr int LM_SEGT = LDS_MISC + 512;
constexpr int LM_SEGC = LDS_MISC + 1024;
constexpr int LM_BASE = LDS_MISC + 1536;
constexpr int LM_PICK = LDS_MISC + 2048;
constexpr int LM_PTRS = LDS_MISC + 4096;
static_assert(LM_PTRS == 155648 + 4096 && LM_PTRS + 192 <= LDS_BYTES, "in_ptr() hard-codes this offset");

__device__ __forceinline__ unsigned f2bf(float f) { unsigned u = __float_as_uint(f); return (u + 0x7fffu + ((u >> 16) & 1u)) >> 16; }
__device__ __forceinline__ unsigned pk2(float lo, float hi) { return f2bf(lo) | (f2bf(hi) << 16); }
__device__ __forceinline__ float bflo(unsigned w) { return __uint_as_float(w << 16); }
__device__ __forceinline__ float bfhi(unsigned w) { return __uint_as_float(w & 0xffff0000u); }
__device__ __forceinline__ float bf2f(bf16_t b) { return __uint_as_float((unsigned)b << 16); }
__device__ __forceinline__ unsigned cvt_pk_bf16(float lo, float hi) { unsigned r; asm volatile("v_cvt_pk_bf16_f32 %0, %1, %2" : "=v"(r) : "v"(lo), "v"(hi)); return r; }
typedef __bf16 bf16x2_t __attribute__((ext_vector_type(2)));
__device__ __forceinline__ unsigned cvtpk(float lo, float hi) { f32x2 v = {lo, hi}; bf16x2_t b = __builtin_convertvector(v, bf16x2_t); return __builtin_bit_cast(unsigned, b); }
template <int M> __device__ __forceinline__ int lane_xor_i(int iv, int lane) {
    if constexpr (M == 1) return __builtin_amdgcn_update_dpp(0, iv, 0xB1, 0xF, 0xF, false);
    else if constexpr (M == 2) return __builtin_amdgcn_update_dpp(0, iv, 0x4E, 0xF, 0xF, false);
    else if constexpr (M == 4) { int t = __builtin_amdgcn_update_dpp(0, iv, 0x104, 0xF, 0x5, false); return __builtin_amdgcn_update_dpp(t, iv, 0x114, 0xF, 0xA, false); }
    else if constexpr (M == 8) return __builtin_amdgcn_update_dpp(0, iv, 0x128, 0xF, 0xF, false);
    else if constexpr (M == 16) { auto rr = __builtin_amdgcn_permlane16_swap((unsigned)iv, (unsigned)iv, false, false); return (int)((lane & 16) ? rr[0] : rr[1]); }
    else { auto rr = __builtin_amdgcn_permlane32_swap((unsigned)iv, (unsigned)iv, false, false); return (int)((lane & 32) ? rr[0] : rr[1]); }
}
template <int M> __device__ __forceinline__ float lane_xor_f(float v, int lane) { return __builtin_bit_cast(float, lane_xor_i<M>(__builtin_bit_cast(int, v), lane)); }
__device__ __forceinline__ float wave_sum(float v) {
    v += lane_xor_f<1>(v, 0); v += lane_xor_f<2>(v, 0); v += lane_xor_f<4>(v, 0); v += lane_xor_f<8>(v, 0);
    { auto rr = __builtin_amdgcn_permlane16_swap(__float_as_uint(v), __float_as_uint(v), false, false); v = __uint_as_float(rr[0]) + __uint_as_float(rr[1]); }
    { auto rr = __builtin_amdgcn_permlane32_swap(__float_as_uint(v), __float_as_uint(v), false, false); v = __uint_as_float(rr[0]) + __uint_as_float(rr[1]); }
    return v;
}
__device__ __forceinline__ float half_sum(float v) {
    v += lane_xor_f<1>(v, 0); v += lane_xor_f<2>(v, 0); v += lane_xor_f<4>(v, 0); v += lane_xor_f<8>(v, 0);
    { auto rr = __builtin_amdgcn_permlane16_swap(__float_as_uint(v), __float_as_uint(v), false, false); v = __uint_as_float(rr[0]) + __uint_as_float(rr[1]); }
    return v;
}
template <int M, int NH>
__device__ __forceinline__ void bfly_step(float* v, int lane) {
#pragma unroll
    for (int i = 0; i < NH; ++i) {
        if constexpr (M == 32) { auto rr = __builtin_amdgcn_permlane32_swap(__float_as_uint(v[i]), __float_as_uint(v[NH + i]), false, false); v[i] = __uint_as_float(rr[0]) + __uint_as_float(rr[1]); }
        else if constexpr (M == 16) { auto rr = __builtin_amdgcn_permlane16_swap(__float_as_uint(v[i]), __float_as_uint(v[NH + i]), false, false); v[i] = __uint_as_float(rr[0]) + __uint_as_float(rr[1]); }
        else { const float lo = v[i] + lane_xor_f<M>(v[i], lane), hi = v[NH + i] + lane_xor_f<M>(v[NH + i], lane); v[i] = (lane & M) ? hi : lo; }
    }
}
template <int N>
__device__ __forceinline__ void bfly_reduce(float (&v)[N], int lane) {
    static_assert(N == 8 || N == 16 || N == 32 || N == 64, "bfly_reduce sizes");
    if constexpr (N == 64) { bfly_step<32, 32>(v, lane); bfly_step<16, 16>(v, lane); bfly_step<8, 8>(v, lane); bfly_step<4, 4>(v, lane); bfly_step<2, 2>(v, lane); bfly_step<1, 1>(v, lane); }
    if constexpr (N == 32) { bfly_step<32, 16>(v, lane); bfly_step<16, 8>(v, lane); bfly_step<8, 4>(v, lane); bfly_step<4, 2>(v, lane); bfly_step<2, 1>(v, lane); v[0] += lane_xor_f<1>(v[0], lane); }
    if constexpr (N == 16) { bfly_step<32, 8>(v, lane); bfly_step<16, 4>(v, lane); bfly_step<8, 2>(v, lane); bfly_step<4, 1>(v, lane); v[0] += lane_xor_f<2>(v[0], lane); v[0] += lane_xor_f<1>(v[0], lane); }
    if constexpr (N == 8) { bfly_step<32, 4>(v, lane); bfly_step<16, 2>(v, lane); bfly_step<8, 1>(v, lane); v[0] += lane_xor_f<4>(v[0], lane); v[0] += lane_xor_f<2>(v[0], lane); v[0] += lane_xor_f<1>(v[0], lane); }
}
#define LDS_WAIT() asm volatile("s_waitcnt lgkmcnt(0)" ::: "memory")
__device__ __forceinline__ const float* in_ptr(LAS unsigned char* lds, int idx) {
    const unsigned long long v = ((const LAS unsigned long long*)(lds + 155648 + 4096))[idx];
    const unsigned lo = __builtin_amdgcn_readfirstlane((unsigned)v), hi = __builtin_amdgcn_readfirstlane((unsigned)(v >> 32));
    return (const float*)(const GAS float*)(((unsigned long long)hi << 32) | lo);
}
#define VM_WAIT() asm volatile("s_waitcnt vmcnt(0)" ::: "memory")

namespace pg8 {
constexpr int BM = 256, BK = 64, HALF = 128, HTB = HALF * BK * 2, STAGE_BYTES = 8 * HTB, NXCD = 8, WGM = 8, KD = 1024, NT = KD / BK;
__host__ __device__ __forceinline__ int lds_byte(int r, int c) { const int st = (r >> 4) * 2 + (c >> 5), rr = r & 15, cc = c & 31, ob = rr * 64 + cc * 2; return st * 1024 + (ob ^ (((ob >> 9) & 1) << 5)); }
__host__ __device__ __forceinline__ void stage_rc(int b, int& R, int& C) { const int st = b / 1024, sb = b % 1024, swz = sb ^ (((sb >> 9) & 1) << 5); R = (st >> 1) * 16 + swz / 64; C = (st & 1) * 32 + (swz % 64) / 2; }
__host__ __device__ __forceinline__ int perm32(int rho) { const int n = rho >> 4, i = rho & 15; return 8 * (i >> 2) + 4 * n + (i & 3); }

struct Unit { int arow0, pm, pn, aux, trow, nval; const char* bptr; };

struct StaticOrder {
    int nM, nN, nwg, G, c, bpitch; const char* Bt;
    __device__ void init(int M, int N, int G_, int c_, const void* Bt_, int bpitch_ = KD * 2) { nM = M / BM; nN = N / BM; nwg = nM * nN; G = G_; c = c_; bpitch = bpitch_; Bt = (const char*)Bt_; }
    __device__ bool next(int i, Unit& u) const {
        const long L = (long)i * G + c; if (L >= nwg) return false;
        int wgid = (int)L; { const int q = nwg / NXCD, r = nwg % NXCD, xcd = wgid % NXCD, off = wgid / NXCD; wgid = (xcd < r ? xcd * (q + 1) : r * (q + 1) + (xcd - r) * q) + off; }
        const int nig = WGM * nN, gid = wgid / nig, fm = gid * WGM, gsz = (nM - fm) < WGM ? (nM - fm) : WGM;
        u.pm = fm + ((wgid % nig) % gsz); u.pn = (wgid % nig) / gsz; u.arow0 = u.pm * BM; u.aux = 0; u.trow = 0; u.nval = 0; u.bptr = Bt + (size_t)u.pn * BM * bpitch; return true;
    }
};
struct IdentityRows { __device__ __forceinline__ int row(const Unit& u, int r) const { return u.arow0 + r; } };
struct TableRows { const int* tab; __device__ __forceinline__ int row(const Unit& u, int r) const { return r < u.nval ? tab[u.trow + r] : 0; } };

typedef int v8i_t __attribute__((ext_vector_type(8)));
template <bool F8 = false, class Epi, class Sched, class RowMap>
__device__ __forceinline__ void gemm_phase(LAS unsigned char* lds, const void* Abase, const Sched& S, const RowMap& RM, const Epi& E) {
    constexpr int PITCH = F8 ? KD : KD * 2, NTK = F8 ? KD / 128 : KD / BK;
    int tid = threadIdx.x; asm volatile("" : "+v"(tid)); tid &= 511;
    const int wid = __builtin_amdgcn_readfirstlane(tid >> 6), lane = tid & 63, wr = wid >> 2, wc = wid & 3, fr = lane & 15, fq = lane >> 4;
    int Rr[2], Cc[2]; unsigned voffB[2];
#pragma unroll
    for (int i = 0; i < 2; ++i) { int R, C; stage_rc(tid * 16 + i * 8192, R, C); int Rb = Epi::PERM ? ((R & ~31) + perm32(R & 31)) : R;
        if constexpr (Epi::PERM16) Rb = 64 * (R >> 5) + 16 * ((R >> 2) & 3) + 4 * ((R >> 4) & 1) + (R & 3);
        Rr[i] = R; Cc[i] = C; voffB[i] = (unsigned)(Rb * PITCH + C * 2); }
    constexpr size_t kstep = (size_t)(BK * 2);
    constexpr size_t hstep = (size_t)(Epi::PERM16 ? 8 : HALF) * PITCH;
    const unsigned ldsw = (unsigned)wid * 1024u;
    const int aoff = F8 ? lds_byte(wr * 64 + fr, fq * 16) : lds_byte(wr * 64 + fr, fq * 8), boff = F8 ? lds_byte(wc * 32 + fr, fq * 16) : lds_byte(wc * 32 + fr, fq * 8);
    const int aoff1 = F8 ? lds_byte(wr * 64 + fr, fq * 16 + 8) : aoff + 1024, boff1 = F8 ? lds_byte(wc * 32 + fr, fq * 16 + 8) : boff + 1024;
    const unsigned lds0 = (unsigned)(unsigned long long)lds;
    unsigned abase0 = lds0 + (unsigned)aoff, bbase0 = lds0 + 65536u + (unsigned)boff;
    asm volatile("" : "+v"(abase0), "+v"(bbase0));
    const unsigned abase1 = abase0 + (F8 ? 16u : 1024u), bbase1 = bbase0 + (F8 ? 16u : 1024u); (void)aoff1; (void)boff1;
#define PG8_SA(b, h) (((b) * 2 + (h)) * HTB)
#define PG8_SB(b, h) ((4 + (b) * 2 + (h)) * HTB)
#define PG8_STAGE(bufoff, gbase, voff) do { _Pragma("unroll") for (int _i = 0; _i < 2; ++_i) { unsigned _keep; \
        asm volatile("s_mov_b32 %0, m0\n\ts_mov_b32 m0, %3\n\ts_nop 0\n\tglobal_load_lds_dwordx4 %1, %2\n\ts_mov_b32 m0, %0" : "=&s"(_keep) : "v"((voff)[_i]), "s"((const char*)(gbase)), \
                     "s"((unsigned)__builtin_amdgcn_readfirstlane((int)(unsigned)(unsigned long long)(lds + (bufoff) + ldsw + _i * 8192))) : "memory"); } } while (0)
#define PG8_RDA(base, off) (*(const LAS u32x4*)(size_t)((base) + (unsigned)(off)))
#define PG8_LDA(dst, b, h) do { _Pragma("unroll") for (int m = 0; m < 4; ++m) { if constexpr (F8) { const u32x4 _lo = PG8_RDA(abase0, PG8_SA(b, h) + m * 2048), _hi = PG8_RDA(abase1, PG8_SA(b, h) + m * 2048); \
        dst##8[m] = (v8i_t){(int)_lo.x, (int)_lo.y, (int)_lo.z, (int)_lo.w, (int)_hi.x, (int)_hi.y, (int)_hi.z, (int)_hi.w}; } \
        else { _Pragma("unroll") for (int k = 0; k < 2; ++k) dst[m][k] = __builtin_bit_cast(bf16x8, PG8_RDA(abase0, PG8_SA(b, h) + m * 2048 + k * 1024)); } } } while (0)
#define PG8_LDB(dst, b, h) do { _Pragma("unroll") for (int n = 0; n < 2; ++n) { if constexpr (F8) { const u32x4 _lo = PG8_RDA(bbase0, PG8_SB(b, h) - 65536 + n * 2048), _hi = PG8_RDA(bbase1, PG8_SB(b, h) - 65536 + n * 2048); \
        dst##8[n] = (v8i_t){(int)_lo.x, (int)_lo.y, (int)_lo.z, (int)_lo.w, (int)_hi.x, (int)_hi.y, (int)_hi.z, (int)_hi.w}; } \
        else { _Pragma("unroll") for (int k = 0; k < 2; ++k) dst[n][k] = __builtin_bit_cast(bf16x8, PG8_RDA(bbase0, PG8_SB(b, h) - 65536 + n * 2048 + k * 1024)); } } } while (0)
#define PG8_MMA(ai, bj, At, Bt) do { __builtin_amdgcn_s_setprio(1); _Pragma("unroll") for (int m = 0; m < 4; ++m) _Pragma("unroll") for (int n = 0; n < 2; ++n) { \
        if constexpr (F8) acc[ai][bj][m][n] = __builtin_amdgcn_mfma_scale_f32_16x16x128_f8f6f4(Bt##8[n], At##8[m], acc[ai][bj][m][n], 0, 0, 0, 0, 0, 0);     \
        else { _Pragma("unroll") for (int k = 0; k < 2; ++k) acc[ai][bj][m][n] = __builtin_amdgcn_mfma_f32_16x16x32_bf16(Bt[n][k], At[m][k], acc[ai][bj][m][n], 0, 0, 0); } } __builtin_amdgcn_s_setprio(0); } while (0)
#define PG8_WAIT_V(n) asm volatile("s_waitcnt vmcnt(" #n ")" ::: "memory")
#define PG8_WAIT_L(n) asm volatile("s_waitcnt lgkmcnt(" #n ")" ::: "memory")
#define PG8_BAR __builtin_amdgcn_s_barrier()
#define PG8_SCHED __builtin_amdgcn_sched_barrier(0)
#define PG8_ROWS(v, u) do { int _t = threadIdx.x; asm volatile("" : "+v"(_t)); _t &= 511; _Pragma("unroll") for (int _i = 0; _i < 2; ++_i) { int _R, _C; stage_rc(_t * 16 + _i * 8192, _R, _C); \
        _Pragma("unroll") for (int _h = 0; _h < 2; ++_h) v[_h][_i] = (unsigned)RM.row((u), _h * HALF + _R) * (unsigned)PITCH + (unsigned)_C * 2u; } } while (0)
    Unit cur, nxt; int ui = 0;
    if (!S.next(0, cur)) return;
    unsigned vc[2][2];
    PG8_ROWS(vc, cur);
#define PG8_VNSLOT ((LAS u32x4*)(lds + 131072) + (threadIdx.x & 511))
    f32x4 acc[2][2][4][2];
#pragma unroll
    for (int a = 0; a < 2; ++a)
#pragma unroll
        for (int b = 0; b < 2; ++b)
#pragma unroll
            for (int m = 0; m < 4; ++m)
#pragma unroll
                for (int n = 0; n < 2; ++n) acc[a][b][m][n] = (f32x4){0.f, 0.f, 0.f, 0.f};
    bf16x8 At[4][2], B0[2][2], B1[2][2]; v8i_t At8[4], B08[2], B18[2];
    const char* cA = (const char*)Abase; const char* cB = cur.bptr;
    PG8_STAGE(PG8_SB(0, 0), cB, voffB); PG8_STAGE(PG8_SB(0, 1), cB + hstep, voffB); PG8_STAGE(PG8_SA(0, 0), cA, vc[0]); PG8_STAGE(PG8_SA(0, 1), cA, vc[1]);
    if (wr == 1) PG8_BAR;
    PG8_WAIT_V(2); PG8_BAR;
    PG8_STAGE(PG8_SB(1, 0), cB + kstep, voffB); PG8_STAGE(PG8_SA(1, 0), cA + kstep, vc[0]); PG8_STAGE(PG8_SB(1, 1), cB + hstep + kstep, voffB);
    PG8_WAIT_V(6); PG8_BAR;
    for (;;) {
        const bool has_next = S.next(ui + 1, nxt);
        { unsigned vn[2][2];
          if (has_next) { PG8_ROWS(vn, nxt); } else {
#pragma unroll
            for (int h = 0; h < 2; ++h)
#pragma unroll
                for (int i = 0; i < 2; ++i) vn[h][i] = vc[h][i]; }
          *PG8_VNSLOT = (u32x4){vn[0][0], vn[0][1], vn[1][0], vn[1][1]}; }
        const char* nB = has_next ? nxt.bptr : cB;
#pragma unroll 1
        for (int t = 0; t < NTK; t += 2) {
            const bool last = (t == NTK - 2);
            const char* a1 = cA + (size_t)(t + 1) * kstep;
            const char* a2 = last ? cA : cA + (size_t)(t + 2) * kstep; const char* b2 = last ? nB : cB + (size_t)(t + 2) * kstep;
            const char* a3 = a2 + kstep; const char* b3 = b2 + kstep;

            PG8_LDB(B0, 0, 0); PG8_LDB(B1, 0, 1); PG8_SCHED; PG8_LDA(At, 0, 0); PG8_STAGE(PG8_SA(1, 1), a1, vc[1]);
            if (last) { const u32x4 q = *PG8_VNSLOT; vc[0][0] = q.x; vc[0][1] = q.y; vc[1][0] = q.z; vc[1][1] = q.w; }
            PG8_WAIT_V(8); PG8_WAIT_L(0); PG8_BAR; PG8_MMA(0, 0, At, B0); PG8_MMA(0, 1, At, B1); PG8_BAR; PG8_SCHED;
            PG8_LDA(At, 0, 1); PG8_STAGE(PG8_SB(0, 0), b2, voffB); PG8_STAGE(PG8_SB(0, 1), b2 + hstep, voffB); PG8_STAGE(PG8_SA(0, 0), a2, vc[0]);
            PG8_WAIT_V(8); PG8_WAIT_L(0); PG8_BAR; PG8_MMA(1, 0, At, B0); PG8_MMA(1, 1, At, B1); PG8_BAR; PG8_SCHED;
            PG8_LDB(B0, 1, 0); PG8_LDB(B1, 1, 1); PG8_SCHED; PG8_LDA(At, 1, 0); PG8_STAGE(PG8_SA(0, 1), a2, vc[1]);
            PG8_WAIT_V(8); PG8_WAIT_L(0); PG8_BAR; PG8_MMA(0, 0, At, B0); PG8_MMA(0, 1, At, B1); PG8_BAR; PG8_SCHED;
            PG8_LDA(At, 1, 1); PG8_STAGE(PG8_SB(1, 0), b3, voffB); PG8_STAGE(PG8_SB(1, 1), b3 + hstep, voffB); PG8_STAGE(PG8_SA(1, 0), a3, vc[0]);
            PG8_WAIT_V(8); PG8_WAIT_L(0); PG8_BAR; PG8_MMA(1, 0, At, B0); PG8_MMA(1, 1, At, B1); PG8_BAR; PG8_SCHED;
        }
        if (wr == 0) PG8_BAR;
        { int _t = threadIdx.x; asm volatile("" : "+v"(_t)); _t &= 511; const int _l = _t & 63; E(acc, cur, wr, wc, _l & 15, _l >> 4); }
        if (!has_next) break;
#pragma unroll
        for (int a = 0; a < 2; ++a)
#pragma unroll
            for (int b = 0; b < 2; ++b)
#pragma unroll
                for (int m = 0; m < 4; ++m)
#pragma unroll
                    for (int n = 0; n < 2; ++n) acc[a][b][m][n] = (f32x4){0.f, 0.f, 0.f, 0.f};
        cur = nxt; cB = nB; ++ui;
        if (wr == 1) PG8_BAR;
    }
    PG8_WAIT_V(0);
    PG8_BAR;
#undef PG8_SA
#undef PG8_SB
#undef PG8_STAGE
#undef PG8_LDA
#undef PG8_LDB
#undef PG8_MMA
#undef PG8_RDA
#undef PG8_WAIT_V
#undef PG8_WAIT_L
#undef PG8_BAR
#undef PG8_SCHED
#undef PG8_ROWS
#undef PG8_VNSLOT
}

struct EpiProj {
    static constexpr bool PERM = true, PERM16 = false;
    bf16_t* O; const f32x2* rope;
    __device__ __forceinline__ void operator()(const f32x4 (&acc)[2][2][4][2], const Unit& u, int wr, int wc, int fr, int fq) const {
        const int row0 = u.pm * BM + wr * 64 + fr, col0 = u.pn * BM + wc * 32 + 8 * fq;
        const bool rot = u.pn < 4; const float sc = u.pn < 2 ? 0.125f * 1.4426950408889634f : 1.0f;
        const int j0 = 16 * (wc & 1) + 4 * fq;
#pragma unroll
        for (int ai = 0; ai < 2; ++ai)
#pragma unroll
            for (int m = 0; m < 4; ++m) {
                const int row = row0 + ai * HALF + m * 16; bf16_t* rowp = O + (size_t)row * PROJW + col0;
                f32x4 cs0 = (f32x4){1.f, 0.f, 1.f, 0.f}, cs1 = cs0;
                if (rot) { const f32x4* rp = (const f32x4*)(rope + (size_t)(row & (SEQ - 1)) * 32 + j0); cs0 = rp[0]; cs1 = rp[1]; }
#pragma unroll
                for (int bj = 0; bj < 2; ++bj) {
                    f32x4 v0 = acc[ai][bj][m][0], v1 = acc[ai][bj][m][1];
                    if (rot) {
                        const f32x4 a = v0, b = v1;
                        v0[0] = a[0] * cs0[0] - a[1] * cs0[1]; v0[1] = a[1] * cs0[0] + a[0] * cs0[1];
                        v0[2] = a[2] * cs0[2] - a[3] * cs0[3]; v0[3] = a[3] * cs0[2] + a[2] * cs0[3];
                        v1[0] = b[0] * cs1[0] - b[1] * cs1[1]; v1[1] = b[1] * cs1[0] + b[0] * cs1[1];
                        v1[2] = b[2] * cs1[2] - b[3] * cs1[3]; v1[3] = b[3] * cs1[2] + b[2] * cs1[3];
                    }
                    v0 = v0 * sc; v1 = v1 * sc;
                    u32x4 w; w.x = cvt_pk_bf16(v0[0], v0[1]); w.y = cvt_pk_bf16(v0[2], v0[3]); w.z = cvt_pk_bf16(v1[0], v1[1]); w.w = cvt_pk_bf16(v1[2], v1[3]);
                    *(u32x4*)(rowp + bj * HALF) = w; }
            }
    }
};
struct EpiOut {
    static constexpr bool PERM = true, PERM16 = false;
    const bf16_t* X; bf16_t* O; float osc;
    __device__ __forceinline__ void operator()(const f32x4 (&acc)[2][2][4][2], const Unit& u, int wr, int wc, int fr, int fq) const {
        const int col0 = u.pn * BM + wc * 32 + 8 * fq;
#pragma unroll
        for (int ai = 0; ai < 2; ++ai)
#pragma unroll
            for (int m = 0; m < 4; ++m) { const size_t off = (size_t)(u.pm * BM + ai * HALF + wr * 64 + m * 16 + fr) * DM + col0;
#pragma unroll
                for (int bj = 0; bj < 2; ++bj) { const u32x4 xw = *(const u32x4*)(X + off + bj * HALF);
                    const f32x4 x0 = (f32x4){bflo(xw.x), bfhi(xw.x), bflo(xw.y), bfhi(xw.y)}, x1 = (f32x4){bflo(xw.z), bfhi(xw.z), bflo(xw.w), bfhi(xw.w)};
                    const f32x4 v0 = x0 * ALPHA + acc[ai][bj][m][0] * osc, v1 = x1 * ALPHA + acc[ai][bj][m][1] * osc;
                    u32x4 w; w.x = cvt_pk_bf16(v0[0], v0[1]); w.y = cvt_pk_bf16(v0[2], v0[3]); w.z = cvt_pk_bf16(v1[0], v1[1]); w.w = cvt_pk_bf16(v1[2], v1[3]);
                    *(u32x4*)(O + off + bj * HALF) = w; } }
    }
};
struct EpiAct {
    static constexpr bool PERM = true, PERM16 = false;
    unsigned char* O; const float* bg; const float* bu; float osc;
    __device__ __forceinline__ void operator()(const f32x4 (&acc)[2][2][4][2], const Unit& u, int wr, int wc, int fr, int fq) const {
        const int ec0 = u.pn * HALF + wc * 32 + 8 * fq;
        const float* bgp = bg + u.aux * 1024 + ec0; const float* bup = bu + u.aux * 1024 + ec0;
        const f32x4 g0b = *(const f32x4*)bgp, g1b = *(const f32x4*)(bgp + 4), u0b = *(const f32x4*)bup, u1b = *(const f32x4*)(bup + 4);
#pragma unroll
        for (int ai = 0; ai < 2; ++ai)
#pragma unroll
            for (int m = 0; m < 4; ++m) {
                const int row = u.pm * BM + ai * HALF + wr * 64 + m * 16 + fr;
                const f32x4 g[2] = {acc[ai][0][m][0] * osc + g0b, acc[ai][0][m][1] * osc + g1b}, uu[2] = {acc[ai][1][m][0] * osc + u0b, acc[ai][1][m][1] * osc + u1b}; float r[8];
#pragma unroll
                for (int n = 0; n < 2; ++n)
#pragma unroll
                    for (int e = 0; e < 4; e += 2) {
                        const f32x2 gv = (f32x2){fminf(g[n][e], 7.0f), fminf(g[n][e + 1], 7.0f)};
                        const f32x2 uv = (f32x2){__builtin_amdgcn_fmed3f(uu[n][e], -7.0f, 7.0f), __builtin_amdgcn_fmed3f(uu[n][e + 1], -7.0f, 7.0f)};
                        const f32x2 t2 = gv * (-1.702f * 1.4426950408889634f);
                        const f32x2 d2 = (f32x2){__builtin_amdgcn_exp2f(t2[0]), __builtin_amdgcn_exp2f(t2[1])} + 1.0f;
                        const f32x2 r2 = (f32x2){__builtin_amdgcn_rcpf(d2[0]), __builtin_amdgcn_rcpf(d2[1])};
                        const f32x2 o2 = __builtin_elementwise_fma(uv, (f32x2){F8_SCALE_A, F8_SCALE_A}, (f32x2){F8_SCALE_A, F8_SCALE_A}) * (gv * r2);
                        r[4 * n + e] = o2[0]; r[4 * n + e + 1] = o2[1]; }
                int lo = __builtin_amdgcn_cvt_pk_fp8_f32(r[0], r[1], 0, false); lo = __builtin_amdgcn_cvt_pk_fp8_f32(r[2], r[3], lo, true);
                int hi = __builtin_amdgcn_cvt_pk_fp8_f32(r[4], r[5], 0, false); hi = __builtin_amdgcn_cvt_pk_fp8_f32(r[6], r[7], hi, true);
                *(u32x2*)(O + (size_t)row * 1024 + ec0) = (u32x2){(unsigned)lo, (unsigned)hi};
            }
    }
};
struct EpiY {
    static constexpr bool PERM = false, PERM16 = true;
    unsigned char* O; const float* bd; float osc;
    __device__ __forceinline__ void operator()(const f32x4 (&acc)[2][2][4][2], const Unit& u, int wr, int wc, int fr, int fq) const {
        const int col0 = u.pn * BM + wc * 64 + 16 * fq; const float* bp = bd + u.aux * 1024 + col0;
        f32x4 bv[2][2];
#pragma unroll
        for (int bj = 0; bj < 2; ++bj)
#pragma unroll
            for (int n = 0; n < 2; ++n) bv[bj][n] = *(const f32x4*)(bp + 8 * bj + 4 * n) * F8_SCALE_Y;
        const float os = osc * F8_SCALE_Y;
#pragma unroll
        for (int ai = 0; ai < 2; ++ai)
#pragma unroll
            for (int m = 0; m < 4; ++m) { unsigned char* rowp = O + (size_t)(u.pm * BM + ai * HALF + wr * 64 + m * 16 + fr) * 1024 + col0; u32x4 w;
#pragma unroll
                for (int bj = 0; bj < 2; ++bj) { f32x4 v0 = acc[ai][bj][m][0] * os + bv[bj][0], v1 = acc[ai][bj][m][1] * os + bv[bj][1];
#pragma unroll
                    for (int e = 0; e < 4; ++e) { v0[e] = __builtin_amdgcn_fmed3f(v0[e], -448.0f, 448.0f); v1[e] = __builtin_amdgcn_fmed3f(v1[e], -448.0f, 448.0f); }
                    int lo = __builtin_amdgcn_cvt_pk_fp8_f32(v0[0], v0[1], 0, false); lo = __builtin_amdgcn_cvt_pk_fp8_f32(v0[2], v0[3], lo, true);
                    int hi = __builtin_amdgcn_cvt_pk_fp8_f32(v1[0], v1[1], 0, false); hi = __builtin_amdgcn_cvt_pk_fp8_f32(v1[2], v1[3], hi, true);
                    if (bj == 0) { w.x = (unsigned)lo; w.y = (unsigned)hi; } else { w.z = (unsigned)lo; w.w = (unsigned)hi; } }
                *(u32x4*)rowp = w; }
    }
};
struct GroupedOrder {
    int t_lo, ntiles, npn, G, c, seg0; const LAS int* segt; const LAS int* segc; const char* W; size_t estride; int pitch;
    mutable int hint;
    __device__ bool next(int i, Unit& u) const {
        const int L = __builtin_amdgcn_readfirstlane(i * G + c); if (L >= ntiles * npn) return false;
        const int tile = t_lo + L / npn, pn = L % npn;
        int s = hint; while (s < seg0 + 31 && segt[s + 1] <= tile) ++s;
        hint = s;
        u.pm = tile - t_lo; u.pn = pn; u.aux = s & 31; u.arow0 = u.pm * BM; { const int ti = tile - segt[s]; u.trow = (s & 31) * NTOK + ti * BM; u.nval = segc[s & 31] - ti * BM; } u.bptr = W + (size_t)(s & 31) * estride + (size_t)pn * BM * pitch; return true;
    }
};
}


typedef short s16x4 __attribute__((ext_vector_type(4)));
typedef short v4i16_t __attribute__((ext_vector_type(4)));
typedef float f32x16 __attribute__((ext_vector_type(16)));
__device__ __forceinline__ s16x4 vtr(const LAS unsigned char* p) { return __builtin_bit_cast(s16x4, __builtin_amdgcn_ds_read_tr16_b64_v4i16((LAS v4i16_t*)p)); }
__device__ __forceinline__ int crow(int r, int hi) { return (r & 3) + 8 * (r >> 2) + 4 * hi; }
constexpr int ATT_VROW = 144;
constexpr int ATT_WLDS = 32 * ATT_VROW + 512;
constexpr int ATT_KBUF = 384 * 128, ATT_V0 = ATT_KBUF, ATT_SC0 = 3 * ATT_KBUF;
static_assert(ATT_SC0 + NWAVES * 512 <= LDS_MISC, "attention LDS map");
template <int DIL>
__device__ __forceinline__ void attn_kdma(const bf16_t* PROJ, int R, LAS unsigned char* kbuf, int wave, int lane) {
    constexpr int L = SEQ / DIL, TPR = L / 32;
    asm volatile("" : "+v"(lane));
    const int idx0 = 8 * R, bh = idx0 >> 7, w0 = idx0 & 127, b = bh >> 3, h = bh & 7, r = w0 / TPR, M0 = 32 * (w0 % TPR);
#pragma unroll
    for (int n = 0; n < 6; ++n) {
        const int row = 8 * (6 * wave + n) + (lane >> 3); int pos = M0 - 64 + row; pos = pos < 0 ? 0 : (pos > L - 1 ? L - 1 : pos);
        const unsigned voff = ((unsigned)(b * SEQ + pos * DIL + r) * PROJW + COL_K + h * 64) * 2u + (unsigned)(((lane & 7) ^ (lane >> 3)) * 16);
        unsigned keep;
        asm volatile("s_mov_b32 %0, m0\n\ts_mov_b32 m0, %3\n\ts_nop 0\n\tglobal_load_lds_dwordx4 %1, %2\n\ts_mov_b32 m0, %0" : "=&s"(keep) : "v"(voff), "s"((const char*)PROJ),
                     "s"((unsigned)__builtin_amdgcn_readfirstlane((int)(unsigned)(unsigned long long)(kbuf + (6 * wave + n) * 1024))) : "memory"); }
}
template <int DIL>
__device__ __forceinline__ void attn_vdma(const bf16_t* PROJ, int R, LAS unsigned char* vbuf, int wave, int lane) {
    constexpr int L = SEQ / DIL, TPR = L / 32;
    asm volatile("" : "+v"(lane));
    const int idx0 = 8 * R, bh = idx0 >> 7, w0 = idx0 & 127, b = bh >> 3, h = bh & 7, r = w0 / TPR, M0 = 32 * (w0 % TPR);
#pragma unroll
    for (int n = 0; n < 6; ++n) {
        const int row = 8 * (6 * wave + n) + (lane >> 3); int pos = M0 - 64 + row; pos = pos < 0 ? 0 : (pos > L - 1 ? L - 1 : pos);
        const unsigned voff = ((unsigned)(b * SEQ + pos * DIL + r) * PROJW + COL_V + h * 64) * 2u + (unsigned)(((lane & 7) ^ (4 * ((lane >> 4) & 1))) * 16);
        unsigned keep;
        asm volatile("s_mov_b32 %0, m0\n\ts_mov_b32 m0, %3\n\ts_nop 0\n\tglobal_load_lds_dwordx4 %1, %2\n\ts_mov_b32 m0, %0" : "=&s"(keep) : "v"(voff), "s"((const char*)PROJ),
                     "s"((unsigned)__builtin_amdgcn_readfirstlane((int)(unsigned)(unsigned long long)(vbuf + (6 * wave + n) * 1024))) : "memory"); }
}
template <int DIL>
__device__ __forceinline__ void attn_qload(const bf16_t* PROJ, int idx, int lane, bf16x8 (&q)[4]) {
    constexpr int TPR = SEQ / DIL / 32;
    const int bh = idx >> 7, w = idx & 127, b = bh >> 3, h = bh & 7, r = w / TPR, m0 = 32 * (w % TPR), i = lane & 31, hi = lane >> 5;
    const unsigned qo = ((unsigned)(b * SEQ + (m0 + i) * DIL + r) * PROJW + COL_Q + h * 64 + 8 * hi) * 2u;
#pragma unroll
    for (int s = 0; s < 4; ++s) q[s] = *(const bf16x8*)((const char*)PROJ + qo + 32 * s);
}
template <int DIL, bool FIRST>
__device__ __forceinline__ void attn_task(bf16_t* PROJ, bf16_t* ATTO, float* ML, int b, int h, int r, int m0, LAS unsigned char* wl, LAS unsigned char* kimg, const LAS unsigned char* vimg, const bf16x8 (&qf)[4],
                                          int wave, int Rnext, int lane) {
    constexpr int L = SEQ / DIL;
    asm volatile("" : "+v"(lane)); lane &= 63;
    const int i = lane & 31, hi = lane >> 5;
    const char* PB = (const char*)PROJ;
    const unsigned tokq = (unsigned)(b * SEQ + (m0 + i) * DIL + r);
    const LAS unsigned char* krow = kimg + (32 * wave + i) * 128;
    float* mlp = (float*)((char*)ML + (tokq * NH + h) * 8u);
    float mp = 0.f, lp = 0.f;
    if (!FIRST) { mp = mlp[0]; lp = mlp[1]; }
    f32x16 S[5];
#pragma unroll
    for (int kb = 0; kb < 5; ++kb) {
        const int mk0 = m0 - 64 + 32 * kb; const bool inr = (mk0 >= 0 && mk0 < L);
        f32x16 acc;
#pragma unroll
        for (int rr = 0; rr < 16; ++rr) acc[rr] = 0.f;
#pragma unroll
        for (int s = 0; s < 4; ++s) { const bf16x8 kf = *(const LAS bf16x8*)(krow + kb * 4096 + (((2 * s + hi) ^ (i & 7)) * 16)); acc = __builtin_amdgcn_mfma_f32_32x32x16_bf16(kf, qf[s], acc, 0, 0, 0); }
        if (kb == 0 || kb == 4) {
#pragma unroll
            for (int rr = 0; rr < 16; ++rr) { const bool ok = inr && (kb == 0 ? (crow(rr, hi) >= i) : (crow(rr, hi) <= i)); S[kb][rr] = ok ? acc[rr] : -INFINITY; }
        } else {
#pragma unroll
            for (int rr = 0; rr < 16; ++rr) S[kb][rr] = inr ? acc[rr] : -INFINITY; }
    }
    asm volatile("s_waitcnt lgkmcnt(0)" ::: "memory");
    __builtin_amdgcn_s_barrier();
    if (Rnext >= 0) attn_kdma<DIL>(PROJ, Rnext, kimg, wave, lane);
    unsigned dmy = 0u;
    if (FIRST) dmy = *(const volatile unsigned*)(PB + tokq * (unsigned)(PROJW * 2));
    char* OB = (char*)ATTO; const unsigned oo = ((unsigned)(b * SEQ + m0 * DIL + r) * 512 + h * 64 + i) * 2u;
    unsigned short pv0[16], pv1[16];
    if (!FIRST) {
#pragma unroll
        for (int rr = 0; rr < 16; ++rr) { const unsigned short* op = (const unsigned short*)(OB + oo + (unsigned)(crow(rr, hi) * DIL * 1024)); pv0[rr] = op[0]; pv1[rr] = op[32]; } }
    float mx = -INFINITY;
#pragma unroll
    for (int kb = 0; kb < 5; ++kb)
#pragma unroll
        for (int rr = 0; rr < 16; ++rr) mx = fmaxf(mx, S[kb][rr]);
    mx = fmaxf(mx, lane_xor_f<32>(mx, lane));
    float lsum = 0.f;
#pragma unroll
    for (int kb = 0; kb < 5; ++kb)
#pragma unroll
        for (int rr = 0; rr < 16; ++rr) { const float pv = __builtin_amdgcn_exp2f(S[kb][rr] - mx); S[kb][rr] = pv; lsum += pv; }
    lsum += lane_xor_f<32>(lsum, lane);
    f32x16 O[2];
#pragma unroll
    for (int rr = 0; rr < 16; ++rr) { O[0][rr] = 0.f; O[1][rr] = 0.f; }
    const int q4 = (lane & 15) >> 2, p4 = lane & 3, blk = (lane >> 4) & 1;
    const LAS unsigned char* vrd = vimg + (32 * wave + 4 * hi + q4) * 128 + (16 * blk + 4 * p4) * 2;
    const int vfl = 64 * ((q4 >> 1) & 1);
#pragma unroll
    for (int kb = 0; kb < 5; ++kb) {
#pragma unroll
        for (int s = 0; s < 2; ++s) {
            u32x4 pw; pw.x = cvtpk(S[kb][8 * s], S[kb][8 * s + 1]); pw.y = cvtpk(S[kb][8 * s + 2], S[kb][8 * s + 3]); pw.z = cvtpk(S[kb][8 * s + 4], S[kb][8 * s + 5]); pw.w = cvtpk(S[kb][8 * s + 6], S[kb][8 * s + 7]);
            const bf16x8 pa = __builtin_bit_cast(bf16x8, pw);
#pragma unroll
            for (int dh = 0; dh < 2; ++dh) {
                const s16x4 lo = vtr(vrd + (32 * kb + 16 * s) * 128 + ((64 * dh) ^ vfl)), hh = vtr(vrd + (32 * kb + 16 * s + 8) * 128 + ((64 * dh) ^ vfl));
                const bf16x8 vf = (bf16x8){lo[0], lo[1], lo[2], lo[3], hh[0], hh[1], hh[2], hh[3]};
                O[dh] = __builtin_amdgcn_mfma_f32_32x32x16_bf16(pa, vf, O[dh], 0, 0, 0);
            }
        }
    }
    float fprev = 0.f, fcur;
    if (FIRST) { fcur = 1.0f / lsum; if (hi == 0) { mlp[0] = mx; mlp[1] = lsum; } }
    else { const float mn = fmaxf(mp, mx); const float aa = __builtin_amdgcn_exp2f(mp - mn) * lp, cc = __builtin_amdgcn_exp2f(mx - mn);
        const float ln = aa + cc * lsum; const float il = 1.0f / ln; fprev = aa * il; fcur = cc * il; if (hi == 0) { mlp[0] = mn; mlp[1] = ln; } }
    LAS float* sc = (LAS float*)wl;
    if (hi == 0) { sc[i] = fprev; sc[32 + i] = fcur; }
    asm volatile("s_waitcnt lgkmcnt(0)" ::: "memory");
#pragma unroll
    for (int rr = 0; rr < 16; ++rr) { const int q = crow(rr, hi); const float fc = sc[32 + q]; bf16_t* op = (bf16_t*)(OB + oo + (unsigned)(q * DIL * 1024));
        float v0 = O[0][rr] * fc, v1 = O[1][rr] * fc;
        if (!FIRST) { const float fp = sc[q]; v0 += __uint_as_float((unsigned)pv0[rr] << 16) * fp; v1 += __uint_as_float((unsigned)pv1[rr] << 16) * fp; }
        op[0] = (bf16_t)f2bf(v0); op[32] = (bf16_t)f2bf(v1); }
    if (FIRST) asm volatile("" :: "v"(dmy));
    asm volatile("s_waitcnt lgkmcnt(0)" ::: "memory");
}
template <int DIL, bool FIRST>
__device__ __forceinline__ void attn_pass(bf16_t* PROJ, bf16_t* ATTO, float* ML, LAS unsigned char* lds, int vcu, int G, int wave, int lane) {
    constexpr int TPR = SEQ / DIL / 32;
    constexpr int NROUND = BATCH * NH * 128 / 8;
    const int per = (NROUND + G - 1) / G, R0 = vcu * per, R1 = (R0 + per < NROUND) ? R0 + per : NROUND;
    if (R0 >= R1) return;
    LAS unsigned char* wl = lds + ATT_SC0 + wave * 512;
    __syncthreads();
    attn_kdma<DIL>(PROJ, R0, lds, wave, lane); attn_vdma<DIL>(PROJ, R0, lds + ATT_V0, wave, lane);
    bf16x8 qn[4]; attn_qload<DIL>(PROJ, 8 * R0 + wave, lane, qn);
    asm volatile("s_waitcnt vmcnt(0)" ::: "memory");
    for (int R = R0; R < R1; ++R) {
        __builtin_amdgcn_s_barrier();
        bf16x8 qf[4];
#pragma unroll
        for (int s = 0; s < 4; ++s) qf[s] = qn[s];
        const bool more = R + 1 < R1;
        if (more) { attn_vdma<DIL>(PROJ, R + 1, lds + ATT_V0 + ((R + 1 - R0) & 1) * ATT_KBUF, wave, lane); attn_qload<DIL>(PROJ, 8 * (R + 1) + wave, lane, qn); }
        const int idx = 8 * R + wave, bh = idx >> 7, w = idx & 127;
        attn_task<DIL, FIRST>(PROJ, ATTO, ML, bh >> 3, bh & 7, w / TPR, 32 * (w % TPR), wl, lds, lds + ATT_V0 + ((R - R0) & 1) * ATT_KBUF, qf, wave, more ? R + 1 : -1, lane); }
    __syncthreads();
}


constexpr int SSD_RS = 272, SSD_RSX = 528;
constexpr int SL_C = 0, SL_B = 34816, SL_X = 69632, SL_TAB = 137216;
static_assert(SL_TAB + 8192 <= LDS_MISC, "SSD LDS map");
__device__ __forceinline__ float bfx(short v) { return __uint_as_float((unsigned)(unsigned short)v << 16); }
__device__ __forceinline__ bf16x8 frag_tr(const LAS unsigned char* img, int RS, int k0, int n0, int lane) {
    const int h2 = lane >> 5, blk = (lane >> 4) & 1, q4 = (lane & 15) >> 2, p4 = lane & 3;
    const LAS unsigned char* p = img + (k0 + 8 * h2 + q4) * RS + (n0 + 16 * blk + 4 * p4) * 2;
    const s16x4 lo = vtr(p), hi = vtr(p + 4 * RS);
    return (bf16x8){lo[0], lo[1], lo[2], lo[3], hi[0], hi[1], hi[2], hi[3]};
}
__device__ __forceinline__ bf16x8 frag_row(const LAS unsigned char* img, int RS, int r0, int k0, int lane) {
    return *(const LAS bf16x8*)(img + (r0 + (lane & 31)) * RS + (k0 + 8 * (lane >> 5)) * 2);
}
__device__ __forceinline__ float ssd_stage(const bf16_t* XBC2, const float* DT, const float* alog_f, const float* alog_b, const float* dtb_f, const float* dtb_b,
                                           int b, int c, int g, bool needC, LAS unsigned char* lds, int tid, int wave, int lane) {
    const size_t t0 = (size_t)b * SEQ + 128 * c;
    {
        const char* XB = (const char*)XBC2 + t0 * 2048;
        u32x4 vb[4], vc[4], vx[8];
#pragma unroll
        for (int k = 0; k < 4; ++k) { const int i = tid + k * NTHREADS, row = i >> 4, pc = i & 15;
            vb[k] = *(const u32x4*)(XB + (unsigned)(row * 2048 + (512 + 128 * g + 8 * pc) * 2));
            if (needC) vc[k] = *(const u32x4*)(XB + (unsigned)(row * 2048 + (768 + 128 * g + 8 * pc) * 2)); }
#pragma unroll
        for (int k = 0; k < 8; ++k) { const int i = tid + k * NTHREADS, row = i >> 5, pc = i & 31; vx[k] = *(const u32x4*)(XB + (unsigned)(row * 2048 + (256 * g + 8 * pc) * 2)); }
#pragma unroll
        for (int k = 0; k < 4; ++k) { const int i = tid + k * NTHREADS, row = i >> 4, pc = i & 15;
            *(LAS u32x4*)(lds + SL_B + row * SSD_RS + pc * 16) = vb[k];
            if (needC) *(LAS u32x4*)(lds + SL_C + row * SSD_RS + pc * 16) = vc[k]; }
#pragma unroll
        for (int k = 0; k < 8; ++k) { const int i = tid + k * NTHREADS, row = i >> 5, pc = i & 31; *(LAS u32x4*)(lds + SL_X + row * SSD_RSX + pc * 16) = vx[k]; }
    }
    const int hh = wave & 3, dir = wave >> 2, h = 4 * g + hh;
    const float A = -expf(dir ? alog_b[h] : alog_f[h]), bias = dir ? dtb_b[h] : dtb_f[h];
    const int s0 = 2 * lane;
    const float r0 = DT[(t0 + s0) * 16 + dir * 8 + h] + bias, r1 = DT[(t0 + s0 + 1) * 16 + dir * 8 + h] + bias;
    const float d0 = r0 > 20.f ? r0 : log1pf(expf(r0)), d1 = r1 > 20.f ? r1 : log1pf(expf(r1));
    const float a0 = d0 * A, a1 = d1 * A, ps = a0 + a1;
    float x = ps;
#pragma unroll
    for (int off = 1; off < 64; off <<= 1) { const float y = __shfl_up(x, off); if (lane >= off) x += y; }
    const float total = __shfl(x, 63), excl = x - ps;
    LAS float* tab = (LAS float*)(lds + SL_TAB + wave * 1024);
    tab[s0] = dir ? total - excl : excl + a0; tab[s0 + 1] = dir ? total - (excl + a0) : x;
    tab[128 + s0] = d0; tab[128 + s0 + 1] = d1;
    return total;
}
__device__ __forceinline__ void ssd_pass_a(const bf16_t* XBC2, const float* DT, bf16_t* ST, float* CD, const float* alog_f, const float* alog_b, const float* dtb_f, const float* dtb_b,
                                           LAS unsigned char* lds, int vcu, int G, int tid, int wave, int lane) {
    for (int unit = vcu; unit < BATCH * 32 * 2; unit += G) {
        const int g = unit & 1, c = (unit >> 1) & 31, b = unit >> 6;
        const float total = ssd_stage(XBC2, DT, alog_f, alog_b, dtb_f, dtb_b, b, c, g, false, lds, tid, wave, lane);
        __syncthreads();
        const int hh = wave & 3, dir = wave >> 2, h = 4 * g + hh, h2 = lane >> 5, hi = h2;
        const size_t sidx = (((size_t)b * 32 + c) * 2 + dir) * 8 + h;
        if (lane == 0) CD[sidx] = expf(total);
        const LAS float* cs = (const LAS float*)(lds + SL_TAB + wave * 1024); const LAS float* dtv = cs + 128;
        f32x16 acc[4][2];
#pragma unroll
        for (int nt = 0; nt < 4; ++nt)
#pragma unroll
            for (int pt = 0; pt < 2; ++pt)
#pragma unroll
                for (int rr = 0; rr < 16; ++rr) acc[nt][pt][rr] = 0.f;
#pragma unroll 2
        for (int ks = 0; ks < 8; ++ks) {
            const f32x4 c0 = *(const LAS f32x4*)(cs + 16 * ks + 8 * h2), c1 = *(const LAS f32x4*)(cs + 16 * ks + 8 * h2 + 4);
            const f32x4 e0 = *(const LAS f32x4*)(dtv + 16 * ks + 8 * h2), e1 = *(const LAS f32x4*)(dtv + 16 * ks + 8 * h2 + 4);
            float sc[8];
#pragma unroll
            for (int j = 0; j < 4; ++j) { sc[j] = e0[j] * __expf(total - c0[j]); sc[4 + j] = e1[j] * __expf(total - c1[j]); }
            bf16x8 xf[2];
#pragma unroll
            for (int pt = 0; pt < 2; ++pt) { const bf16x8 raw = frag_tr(lds + SL_X, SSD_RSX, 16 * ks, 64 * hh + 32 * pt, lane);
                u32x4 w; w.x = cvtpk(bfx(raw[0]) * sc[0], bfx(raw[1]) * sc[1]); w.y = cvtpk(bfx(raw[2]) * sc[2], bfx(raw[3]) * sc[3]); w.z = cvtpk(bfx(raw[4]) * sc[4], bfx(raw[5]) * sc[5]); w.w = cvtpk(bfx(raw[6]) * sc[6], bfx(raw[7]) * sc[7]);
                xf[pt] = __builtin_bit_cast(bf16x8, w); }
#pragma unroll
            for (int nt = 0; nt < 4; ++nt) { const bf16x8 af = frag_tr(lds + SL_B, SSD_RS, 16 * ks, 32 * nt, lane);
#pragma unroll
                for (int pt = 0; pt < 2; ++pt) acc[nt][pt] = __builtin_amdgcn_mfma_f32_32x32x16_bf16(af, xf[pt], acc[nt][pt], 0, 0, 0); }
        }
        bf16_t* sp = ST + sidx * 8192;
#pragma unroll
        for (int nt = 0; nt < 4; ++nt)
#pragma unroll
            for (int pt = 0; pt < 2; ++pt)
#pragma unroll
                for (int rg = 0; rg < 4; ++rg) { u32x2 w; w.x = cvtpk(acc[nt][pt][4 * rg], acc[nt][pt][4 * rg + 1]); w.y = cvtpk(acc[nt][pt][4 * rg + 2], acc[nt][pt][4 * rg + 3]);
                    *(u32x2*)(sp + (32 * pt + (lane & 31)) * 128 + 32 * nt + 8 * rg + 4 * hi) = w; }
        __syncthreads();
    }
}
__device__ __forceinline__ void ssd_pass_b(bf16_t* ST, const float* CD, int gtid, int nthreads) {
    for (int idx = gtid; idx < BATCH * 2 * 8 * 64 * 16; idx += nthreads) {
        const int n8 = idx & 15, p = (idx >> 4) & 63, h = (idx >> 10) & 7, dir = (idx >> 13) & 1, b = idx >> 14;
        const size_t cstride = (size_t)2 * 8 * 8192;
        bf16_t* base = ST + (((size_t)b * 32 * 2 + dir) * 8 + h) * 8192 + p * 128 + 8 * n8;
        const float* cdb = CD + ((size_t)b * 32 * 2 + dir) * 8 + h;
        float run[8];
#pragma unroll
        for (int e = 0; e < 8; ++e) run[e] = 0.f;
#pragma unroll 1
        for (int half = 0; half < 2; ++half) {
            u32x4 w[16]; float dec[16];
#pragma unroll
            for (int i = 0; i < 16; ++i) { const int c = dir ? 31 - (16 * half + i) : 16 * half + i; w[i] = *(const u32x4*)(base + c * cstride); dec[i] = cdb[c * 16]; }
#pragma unroll
            for (int i = 0; i < 16; ++i) { const int c = dir ? 31 - (16 * half + i) : 16 * half + i;
                u32x4 o; o.x = cvtpk(run[0], run[1]); o.y = cvtpk(run[2], run[3]); o.z = cvtpk(run[4], run[5]); o.w = cvtpk(run[6], run[7]); *(u32x4*)(base + c * cstride) = o;
                const float d = dec[i]; run[0] = run[0] * d + bflo(w[i].x); run[1] = run[1] * d + bfhi(w[i].x); run[2] = run[2] * d + bflo(w[i].y); run[3] = run[3] * d + bfhi(w[i].y);
                run[4] = run[4] * d + bflo(w[i].z); run[5] = run[5] * d + bfhi(w[i].z); run[6] = run[6] * d + bflo(w[i].w); run[7] = run[7] * d + bfhi(w[i].w); }
        }
    }
}
constexpr int SSD_RSY = 1040;
__device__ __forceinline__ void ssd_pass_c(const bf16_t* XBC2, const float* DT, const bf16_t* ST, const bf16_t* PROJ, unsigned char* MIX, const float* alog_f, const float* alog_b, const float* dtb_f, const float* dtb_b,
                                           const float* dskip, const float* normw, LAS unsigned char* lds, int vcu, int G, int tid, int wave, int lane) {
    for (int unit = vcu; unit < BATCH * 32 * 2; unit += G) {
        const int g = unit & 1, c = (unit >> 1) & 31, b = unit >> 6;
        const int h2 = lane >> 5, hi = h2, l31 = lane & 31;
        const int hh = wave & 3, lh = wave >> 2, h = 4 * g + hh;
        bf16x8 pf[8][2];
        { const bf16_t* pp = ST + ((((size_t)b * 32 + c) * 2 + 0) * 8 + h) * 8192;
#pragma unroll
          for (int ks = 0; ks < 8; ++ks)
#pragma unroll
              for (int pt = 0; pt < 2; ++pt) pf[ks][pt] = *(const bf16x8*)(pp + (32 * pt + l31) * 128 + 16 * ks + 8 * h2); }
        (void)ssd_stage(XBC2, DT, alog_f, alog_b, dtb_f, dtb_b, b, c, g, true, lds, tid, wave, lane);
        __syncthreads();
        {
            const int lt = wave >> 1; f32x16 cb[2];
#pragma unroll
            for (int q = 0; q < 2; ++q)
#pragma unroll
                for (int rr = 0; rr < 16; ++rr) cb[q][rr] = 0.f;
#pragma unroll 2
            for (int ks = 0; ks < 8; ++ks) { const bf16x8 bf = frag_row(lds + SL_C, SSD_RS, 32 * lt, 16 * ks, lane);
#pragma unroll
                for (int q = 0; q < 2; ++q) { const bf16x8 af = frag_row(lds + SL_B, SSD_RS, 32 * (2 * (wave & 1) + q), 16 * ks, lane); cb[q] = __builtin_amdgcn_mfma_f32_32x32x16_bf16(af, bf, cb[q], 0, 0, 0); } }
            __syncthreads();
#pragma unroll
            for (int q = 0; q < 2; ++q)
#pragma unroll
                for (int rg = 0; rg < 4; ++rg) { u32x2 w; w.x = cvtpk(cb[q][4 * rg], cb[q][4 * rg + 1]); w.y = cvtpk(cb[q][4 * rg + 2], cb[q][4 * rg + 3]);
                    *(LAS u32x2*)(lds + SL_B + (32 * lt + l31) * SSD_RS + (32 * (2 * (wave & 1) + q) + 8 * rg + 4 * hi) * 2) = w; }
            __syncthreads();
        }
        const float Dh = dskip[h];
        f32x16 Yc[2][2];
#pragma unroll
        for (int lt = 0; lt < 2; ++lt)
#pragma unroll
            for (int pt = 0; pt < 2; ++pt)
#pragma unroll
                for (int rr = 0; rr < 16; ++rr) Yc[lt][pt][rr] = 0.f;
#pragma unroll
        for (int dir = 0; dir < 2; ++dir) {
            const LAS float* cs = (const LAS float*)(lds + SL_TAB + (dir * 4 + hh) * 1024); const LAS float* dtv = cs + 128;
            {
                const float el0 = __expf(cs[64 * lh + l31]), el1 = __expf(cs[64 * lh + 32 + l31]);
#pragma unroll
                for (int ks = 0; ks < 8; ++ks) {
#pragma unroll
                    for (int lt = 0; lt < 2; ++lt) { const bf16x8 raw = frag_row(lds + SL_C, SSD_RS, 64 * lh + 32 * lt, 16 * ks, lane); const float el = lt ? el1 : el0;
                        u32x4 w; w.x = cvtpk(bfx(raw[0]) * el, bfx(raw[1]) * el); w.y = cvtpk(bfx(raw[2]) * el, bfx(raw[3]) * el); w.z = cvtpk(bfx(raw[4]) * el, bfx(raw[5]) * el); w.w = cvtpk(bfx(raw[6]) * el, bfx(raw[7]) * el);
                        const bf16x8 af = __builtin_bit_cast(bf16x8, w);
#pragma unroll
                        for (int pt = 0; pt < 2; ++pt) Yc[lt][pt] = __builtin_amdgcn_mfma_f32_32x32x16_bf16(af, pf[ks][pt], Yc[lt][pt], 0, 0, 0); }
                    __builtin_amdgcn_sched_barrier(0); }
            }
            if (dir == 0) {
                const bf16_t* pp = ST + ((((size_t)b * 32 + c) * 2 + 1) * 8 + h) * 8192;
#pragma unroll
                for (int ks = 0; ks < 8; ++ks)
#pragma unroll
                    for (int pt = 0; pt < 2; ++pt) pf[ks][pt] = *(const bf16x8*)(pp + (32 * pt + l31) * 128 + 16 * ks + 8 * h2); }
#pragma unroll 1
            for (int ks = 0; ks < 8; ++ks) {
                const bool need0 = dir ? (16 * ks + 15 >= 64 * lh) : (16 * ks <= 64 * lh + 31), need1 = dir ? (16 * ks + 15 >= 64 * lh + 32) : (16 * ks <= 64 * lh + 63);
                if (!(need0 || need1)) continue;
                bf16x8 xf[2];
#pragma unroll
                for (int pt = 0; pt < 2; ++pt) xf[pt] = frag_tr(lds + SL_X, SSD_RSX, 16 * ks, 64 * hh + 32 * pt, lane);
                const f32x4 c0 = *(const LAS f32x4*)(cs + 16 * ks + 8 * h2), c1 = *(const LAS f32x4*)(cs + 16 * ks + 8 * h2 + 4);
                const f32x4 e0 = *(const LAS f32x4*)(dtv + 16 * ks + 8 * h2), e1 = *(const LAS f32x4*)(dtv + 16 * ks + 8 * h2 + 4);
#pragma unroll
                for (int lt = 0; lt < 2; ++lt) { if (!(lt ? need1 : need0)) continue;
                    const int l = 64 * lh + 32 * lt + l31; const float csl = cs[l];
                    const bf16x8 cbv = frag_row(lds + SL_B, SSD_RS, 64 * lh + 32 * lt, 16 * ks, lane);
                    float gv[8];
#pragma unroll
                    for (int j = 0; j < 8; ++j) { const int sidx = 16 * ks + 8 * h2 + j; const float cj = j < 4 ? c0[j] : c1[j - 4], dj = j < 4 ? e0[j] : e1[j - 4];
                        const bool ok = dir ? (sidx >= l) : (sidx <= l); float gg = ok ? bfx(cbv[j]) * __expf(csl - cj) * dj : 0.f; if (dir == 0 && sidx == l) gg += Dh; gv[j] = gg; }
                    u32x4 w; w.x = cvtpk(gv[0], gv[1]); w.y = cvtpk(gv[2], gv[3]); w.z = cvtpk(gv[4], gv[5]); w.w = cvtpk(gv[6], gv[7]);
                    const bf16x8 af = __builtin_bit_cast(bf16x8, w);
#pragma unroll
                    for (int pt = 0; pt < 2; ++pt) Yc[lt][pt] = __builtin_amdgcn_mfma_f32_32x32x16_bf16(af, xf[pt], Yc[lt][pt], 0, 0, 0); }
            }
        }
        __syncthreads();
        { LAS unsigned char* yimg = lds + (64 * lh) * SSD_RSY + (64 * hh + l31) * 4;
#pragma unroll
          for (int lt = 0; lt < 2; ++lt)
#pragma unroll
              for (int pt = 0; pt < 2; ++pt)
#pragma unroll
                  for (int rr = 0; rr < 16; ++rr) *(LAS float*)(yimg + (32 * lt + crow(rr, hi)) * SSD_RSY + 32 * pt * 4) = Yc[lt][pt][rr]; }
        __syncthreads();
        {
            const f32x4 nw = *(const f32x4*)(normw + 256 * g + 4 * lane);
#pragma unroll 4
            for (int rr = 0; rr < 16; ++rr) { const int l = wave * 16 + rr; const size_t tok = (size_t)b * SEQ + 128 * c + l;
                const f32x4 y = *(const LAS f32x4*)(lds + l * SSD_RSY + 16 * lane);
                const u32x2 zw = *(const u32x2*)(PROJ + tok * PROJW + COL_Z + 256 * g + 4 * lane);
                const f32x4 z = (f32x4){bflo(zw.x), bfhi(zw.x), bflo(zw.y), bfhi(zw.y)};
                f32x4 v;
#pragma unroll
                for (int e = 0; e < 4; ++e) v[e] = y[e] * z[e] * __builtin_amdgcn_rcpf(1.0f + __expf(-z[e]));
                const float ss = wave_sum((v[0] * v[0] + v[1] * v[1]) + (v[2] * v[2] + v[3] * v[3]));
                const float r = 1.0f / sqrtf(ss * (1.0f / 256.0f) + EPS);
                const float r16 = r * F8_SCALE_M;
                int o = __builtin_amdgcn_cvt_pk_fp8_f32(v[0] * r16 * nw[0], v[1] * r16 * nw[1], 0, false); o = __builtin_amdgcn_cvt_pk_fp8_f32(v[2] * r16 * nw[2], v[3] * r16 * nw[3], o, true);
                *(int*)(MIX + tok * 1024 + 512 + 256 * g + 4 * lane) = o; }
        }
        __syncthreads();
    }
}

#define XB_TMO      128
#define XB_XCNT(j)  (256  + 64 * (j))
#define XB_XSUB(j)  (1280 + 64 * (j))
#define XB_XGEN(j)  (2304 + 64 * (j))
#define XB_TOP      3328
#define XB_TOPGEN   3392
#define XCD_BAR_WORDS 3456
#define XB_SPIN_CAP (1u << 18)
__device__ __forceinline__ unsigned xb_ld(unsigned* p)              { return __hip_atomic_load(p, __ATOMIC_RELAXED, __HIP_MEMORY_SCOPE_AGENT); }
__device__ __forceinline__ unsigned xb_add(unsigned* p, unsigned v) { return __hip_atomic_fetch_add(p, v, __ATOMIC_RELAXED, __HIP_MEMORY_SCOPE_AGENT); }
__device__ __forceinline__ unsigned xb_xcc_id() { return (unsigned)__builtin_amdgcn_s_getreg((3 << 11) | 20) & 0xFu; }
#define XB_SPIN(cond, bar) do { unsigned _sp = 0; while (cond) { __builtin_amdgcn_s_sleep(1); \
    if ((++_sp & 255u) == 0u) { if (xb_ld(&(bar)[XB_TMO])) break; if (_sp > XB_SPIN_CAP) { atomicAdd(&(bar)[XB_TMO], 1u); break; } } } } while (0)
struct XcdBarrier { unsigned* bar; unsigned x; volatile LAS unsigned* st; };
__device__ __forceinline__ XcdBarrier xcd_barrier_post(unsigned* bar, volatile LAS unsigned* st) {
    XcdBarrier b; b.bar = bar; b.x = xb_xcc_id(); b.st = st;
    if (threadIdx.x == 0) (void)xb_add(&bar[XB_XCNT(b.x)], 1u);
    return b;
}
__device__ __forceinline__ void xcd_barrier_complete(unsigned* bar, unsigned x, unsigned& nloc, unsigned& nx) {
    const unsigned G = gridDim.x * gridDim.y * gridDim.z;
    unsigned sum, cnt, mine, sp = 0u;
    for (;;) {
        sum = 0u; cnt = 0u; mine = 0u;
#pragma unroll
        for (unsigned j = 0; j < 16; ++j) { const unsigned c = xb_ld(&bar[XB_XCNT(j)]); sum += c; cnt += (c > 0u) ? 1u : 0u; mine = (j == x) ? c : mine; }
        if (sum == G) break;
        __builtin_amdgcn_s_sleep(1);
        if ((++sp & 255u) == 0u) { if (xb_ld(&bar[XB_TMO])) break; if (sp > XB_SPIN_CAP) { atomicAdd(&bar[XB_TMO], 1u); break; } }
    }
    nloc = mine > 0u ? mine : 1u; nx = cnt > 0u ? cnt : 1u;
}
__device__ __forceinline__ void xcd_barrier(const XcdBarrier& b) {
    asm volatile("s_waitcnt vmcnt(0)" ::: "memory");
    __syncthreads();
    if (threadIdx.x == 0) {
        unsigned* bar = b.bar;
        __builtin_amdgcn_s_waitcnt(0);
        unsigned nloc = b.st[0], nx = b.st[1];
        if (nloc == 0u) { xcd_barrier_complete(bar, b.x, nloc, nx); b.st[0] = nloc; b.st[1] = nx; }
        const unsigned old = xb_add(&bar[XB_XSUB(b.x)], 1u);
        const unsigned gen = old / nloc;
        if (old + 1u == (gen + 1u) * nloc) {
            __builtin_amdgcn_fence(__ATOMIC_RELEASE, "agent");
            asm volatile("s_waitcnt vmcnt(0)" ::: "memory");
            const unsigned og = xb_add(&bar[XB_TOP], 1u);
            const unsigned tg = og / nx;
            if (og + 1u == (tg + 1u) * nx) xb_add(&bar[XB_TOPGEN], 1u);
            else XB_SPIN(xb_ld(&bar[XB_TOPGEN]) == tg, bar);
            __builtin_amdgcn_fence(__ATOMIC_ACQUIRE, "agent");
            xb_add(&bar[XB_XGEN(b.x)], 1u);
            asm volatile("s_waitcnt vmcnt(0)" ::: "memory");
        } else {
            XB_SPIN(xb_ld(&bar[XB_XGEN(b.x)]) == gen, bar);
            __builtin_amdgcn_fence(__ATOMIC_ACQUIRE, "agent");
            asm volatile("s_waitcnt vmcnt(0)" ::: "memory");
        }
    }
    __syncthreads();
}

struct Args { const float* in[24]; float* out; unsigned char* ws; int ph_lo, ph_hi; };
enum { I_X = 0, I_W_IN, I_ATTN_NORM_W, I_CONV_W, I_CONV_B, I_DT_BIAS_F, I_A_LOG_F, I_DT_BIAS_B, I_A_LOG_B, I_D_SKIP, I_SSD_NORM_W,
       I_W_OUT, I_LN1_W, I_LN1_B, I_ROUTER_W, I_ROUTER_B, I_W_GATE, I_B_GATE, I_W_UP, I_B_UP, I_W_DOWN, I_B_DOWN, I_LN2_W, I_LN2_B };
#define INP(name) in_ptr(lds, I_##name)

__device__ __forceinline__ void transpose_item(const float* W, int ldw, int k0, int n0, bf16_t* WT, int dbase, int dmul, LAS float* scr, int lane) {
    float v[32];
    const float* wp = W + (size_t)(k0 + (lane >> 5)) * ldw + n0 + (lane & 31);
#pragma unroll
    for (int i = 0; i < 32; ++i) v[i] = wp[(size_t)(2 * i) * ldw];
#pragma unroll
    for (int i = 0; i < 32; ++i) scr[(2 * i + (lane >> 5)) * 33 + (lane & 31)] = v[i];
    LDS_WAIT(); asm volatile("" ::: "memory");
    const int c = lane & 7;
#pragma unroll
    for (int j = 0; j < 4; ++j) { const int n = (lane >> 3) + 8 * j; const LAS float* sp = scr + (8 * c) * 33 + n;
        u32x4 o; o.x = cvtpk(sp[0 * 33], sp[1 * 33]); o.y = cvtpk(sp[2 * 33], sp[3 * 33]); o.z = cvtpk(sp[4 * 33], sp[5 * 33]); o.w = cvtpk(sp[6 * 33], sp[7 * 33]);
        *(u32x4*)(WT + (size_t)(dbase + dmul * n) * 1024 + k0 + 8 * c) = o; }
    LDS_WAIT(); asm volatile("" ::: "memory");
}

__device__ __forceinline__ void transpose_item_f8(const float* W, int ldw, int k0, int n0, unsigned char* WT, int dbase, float sc, LAS float* scr, int lane) {
    float v[32];
    const float* wp = W + (size_t)(k0 + (lane >> 5)) * ldw + n0 + (lane & 31);
#pragma unroll
    for (int i = 0; i < 32; ++i) v[i] = wp[(size_t)(2 * i) * ldw];
#pragma unroll
    for (int i = 0; i < 32; ++i) scr[(2 * i + (lane >> 5)) * 33 + (lane & 31)] = v[i] * sc;
    LDS_WAIT(); asm volatile("" ::: "memory");
    const int c = lane & 7;
#pragma unroll
    for (int j = 0; j < 4; ++j) { const int n = (lane >> 3) + 8 * j; const LAS float* sp = scr + (8 * c) * 33 + n;
        int lo = __builtin_amdgcn_cvt_pk_fp8_f32(sp[0 * 33], sp[1 * 33], 0, false); lo = __builtin_amdgcn_cvt_pk_fp8_f32(sp[2 * 33], sp[3 * 33], lo, true);
        int hi = __builtin_amdgcn_cvt_pk_fp8_f32(sp[4 * 33], sp[5 * 33], 0, false); hi = __builtin_amdgcn_cvt_pk_fp8_f32(sp[6 * 33], sp[7 * 33], hi, true);
        *(u32x2*)(WT + (size_t)(dbase + n) * 1024 + k0 + 8 * c) = (u32x2){(unsigned)lo, (unsigned)hi}; }
    LDS_WAIT(); asm volatile("" ::: "memory");
}

__global__ void __launch_bounds__(NTHREADS, 2) hymba_fwd(Args a) {
    extern __shared__ __attribute__((aligned(16))) unsigned char lds_raw[];
    LAS unsigned char* lds = (LAS unsigned char*)lds_raw;
    const int tid0 = threadIdx.x, wave = __builtin_amdgcn_readfirstlane(tid0 >> 6);
    int tid = tid0; const int lane = tid & 63;
    const int G = gridDim.x; const int bx = blockIdx.x; const int vcu = (G % 8 == 0) ? (bx % 8) * (G / 8) + bx / 8 : bx;
    const int gw = vcu * NWAVES + wave, NGW = G * NWAVES;
    unsigned char* ws = a.ws;
    unsigned* ctl = (unsigned*)(ws + WS_CTL);
    f32x2* rope = (f32x2*)(ws + WS_ROPE);
    bf16_t* WIN = (bf16_t*)(ws + WS_WIN); bf16_t* WOUT = (bf16_t*)(ws + WS_WOUT); bf16_t* WGU = (bf16_t*)(ws + WS_WGU);
    unsigned char* WDN8 = ws + WS_WDN;
    float* TOPG = (float*)(ws + RT_TOPG);
    int* TOKV = (int*)(ws + WS_WIN); int* ROWOF = (int*)(ws + RT_YROW); int* GCNT = (int*)(ws + WS_CTL + 65536);
    float* DT = (float*)(ws + WS_DT);
    unsigned* WQ = (unsigned*)(ws + WS_CTL + 98304);
    bf16_t* XB = (bf16_t*)(ws + WS_XB); unsigned char* MIX8 = (unsigned char*)a.out; unsigned char* WOUT8 = ws + WS_WOUT;     bf16_t* H1 = (bf16_t*)(ws + WS_H1);
    bf16_t* PROJ = (bf16_t*)(ws + WS_PROJ); bf16_t* XBC2 = (bf16_t*)(ws + WS_XBC2); bf16_t* ATTO = (bf16_t*)(ws + WS_ATTO);
    unsigned char* ACT8 = ws + WS_ACT; unsigned char* Y8 = ws + WS_Y;
    float* ML = (float*)(ws + WS_ML); unsigned char* H1F8 = ws + WS_H1F8; unsigned char* WGU8 = ws + WS_WGU;
    bf16_t* ST = (bf16_t*)((unsigned char*)a.out + 64 * MiB); float* CD = (float*)(ws + RT_CD);
    float* YD = a.out;
    bf16_t* PRE1 = (bf16_t*)((unsigned char*)a.out + 64 * MiB);

    for (int u = tid; u < (LDS_BYTES - LDS_MISC) / 4; u += NTHREADS) ((LAS unsigned*)(lds + LDS_MISC))[u] = 0u;
    if (tid < 24) ((LAS unsigned long long*)(lds + LM_PTRS))[tid] = (unsigned long long)a.in[tid];
    __syncthreads();
    XcdBarrier bar = xcd_barrier_post(ctl + CW_BAR, (volatile LAS unsigned*)(lds + LM_BAR));
#define IN(k) true
#define SEAM(k) do { if (IN(k) && IN((k) + 1)) xcd_barrier(bar); } while (0)
#ifndef RPMASK
#define RPMASK 0
#endif
#define REP(k) for (int _r = 0; _r < ((((RPMASK) >> (k)) & 1) ? 2 : 1); ++_r)

    constexpr int NEI = 3 * NE * 512;
    unsigned* QW = WQ + 192;
    auto expert_item = [&](int r) {
        int ln = threadIdx.x; asm volatile("" : "+v"(ln)); ln &= 63;
        LAS float* scr = (LAS float*)(lds + wave * 16384);
        const int which = r / (NE * 512); r -= which * (NE * 512); const int e = r >> 9, q = r & 511, kb = q >> 5, n0 = 32 * (q & 31);
        if (which == 2) transpose_item_f8(INP(W_DOWN) + (size_t)e * 1024 * 1024, 1024, 64 * kb, n0, WDN8 + (size_t)e * 1024 * 1024, n0, F8_SCALE_D, scr, ln);
        else transpose_item_f8((which ? INP(W_UP) : INP(W_GATE)) + (size_t)e * 1024 * 1024, 1024, 64 * kb, n0, WGU8 + (size_t)e * 2048 * 1024, (n0 >> 7) * 256 + which * 128 + (n0 & 127), F8_SCALE_W, scr, ln);
    };
    auto steal_wait = [&]() {
        volatile LAS int* sw = (volatile LAS int*)(lds + LM_STEAL);
        asm volatile("s_waitcnt vmcnt(0)" ::: "memory");
        __syncthreads();
        unsigned gen = 0u, tg = 0u; int role = 0;
        unsigned* bw = bar.bar;
        if (threadIdx.x == 0) {
            __builtin_amdgcn_s_waitcnt(0);
            unsigned nloc = bar.st[0], nx = bar.st[1];
            if (nloc == 0u) { xcd_barrier_complete(bw, bar.x, nloc, nx); bar.st[0] = nloc; bar.st[1] = nx; }
            const unsigned old = xb_add(&bw[XB_XSUB(bar.x)], 1u);
            gen = old / nloc;
            if (old + 1u == (gen + 1u) * nloc) {
                __builtin_amdgcn_fence(__ATOMIC_RELEASE, "agent");
                asm volatile("s_waitcnt vmcnt(0)" ::: "memory");
                const unsigned og = xb_add(&bw[XB_TOP], 1u);
                tg = og / nx; role = 1;
                if (og + 1u == (tg + 1u) * nx) { xb_add(&bw[XB_TOPGEN], 1u); role = 2; }
            }
        }
        for (unsigned sp = 0u; ; ++sp) {
            if (threadIdx.x == 0) {
                bool open = role == 2 ? true : (role == 1 ? xb_ld(&bw[XB_TOPGEN]) != tg : xb_ld(&bw[XB_XGEN(bar.x)]) != gen);
                if (!open && (sp & 63u) == 63u) { if (xb_ld(&bw[XB_TMO])) open = true; else if (sp > XB_SPIN_CAP) { atomicAdd(&bw[XB_TMO], 1u); open = true; } }
                int base = NEI;
                if (open) { __builtin_amdgcn_fence(__ATOMIC_ACQUIRE, "agent"); if (role != 0) xb_add(&bw[XB_XGEN(bar.x)], 1u); asm volatile("s_waitcnt vmcnt(0)" ::: "memory"); }
                else if (sw[2] == 0) { base = (int)xb_add(QW, 8u); if (base >= NEI) { base = NEI; sw[2] = 1; } }
                sw[0] = open ? 1 : 0; sw[1] = base;
            }
            __syncthreads();
            const int open = sw[0], base = sw[1];
            if (open) break;
            if (base < NEI) expert_item(base + wave); else __builtin_amdgcn_s_sleep(4);
            __syncthreads();
        }
        __syncthreads();
    };
    auto steal_drain = [&]() {
        volatile LAS int* sw = (volatile LAS int*)(lds + LM_STEAL);
        for (;;) { __syncthreads(); if (threadIdx.x == 0) sw[1] = (int)xb_add(QW, 8u); __syncthreads(); const int base = sw[1]; if (base >= NEI) break; expert_item(base + wave); }
        xcd_barrier(bar);
    };

    REP(0) if (IN(0)) {
        int tid = threadIdx.x; asm volatile("" : "+v"(tid)); tid &= 511; const int lane = tid & 63; (void)lane;
        for (int i = gw * 64 + lane; i < SEQ * 32; i += NGW * 64) { const int pos = i >> 5, j = i & 31;
            const float inv = powf(10000.0f, -(float)j / 32.0f); const float ang = (float)pos * inv; float s, c; sincosf(ang, &s, &c); rope[i] = (f32x2){c, s}; }
        LAS float* scr = (LAS float*)(lds + wave * 16384);
        constexpr int I_IN = 16 * 96, I_OUT = 16 * 32;
        constexpr int NITEMS = I_IN + I_OUT;
        for (int it = gw; it < NITEMS; it += NGW) {
            int r = it;
            if (r < I_IN) { const int kb = r / 96, nb = r % 96, n0 = 32 * nb;
                if (n0 < 1024) transpose_item(INP(W_IN), WIN_LD, 64 * kb, n0, WIN, (n0 & ~63) + ((n0 >> 5) & 1), 2, scr, lane);
                else transpose_item(INP(W_IN), WIN_LD, 64 * kb, n0, WIN, n0, 1, scr, lane);
                continue; } r -= I_IN;
            transpose_item_f8(INP(W_OUT), 1024, 64 * (r / 32), 32 * (r % 32), WOUT8, 32 * (r % 32), F8_SCALE_D, scr, lane);
        }
        __syncthreads();
        LAS float* wdt = (LAS float*)lds;
        { const float* wi = INP(W_IN);
#pragma unroll 1
          for (int b0 = 0; b0 < 32; b0 += 16) { float t[16];
#pragma unroll
              for (int u = 0; u < 16; ++u) { const int i = tid + (b0 + u) * NTHREADS; t[u] = wi[(size_t)(i >> 4) * WIN_LD + 3072 + (i & 15)]; }
#pragma unroll
              for (int u = 0; u < 16; ++u) { const int i = tid + (b0 + u) * NTHREADS; wdt[(i & 15) * 1024 + (i >> 4)] = t[u]; } } }
        __syncthreads();
        {
            const float* X = INP(X);
            f32x4 v[2][4], vn[2][4];
            int row = gw;
#pragma unroll
            for (int q = 0; q < 2; ++q)
#pragma unroll
                for (int j = 0; j < 4; ++j) v[q][j] = ((const f32x4*)(X + (size_t)(row + q * NGW) * DM) + lane)[64 * j];
            for (; row < NTOK; row += 2 * NGW) {
                const int nrow = row + 2 * NGW;
                if (nrow < NTOK) {
#pragma unroll
                    for (int q = 0; q < 2; ++q)
#pragma unroll
                        for (int j = 0; j < 4; ++j) vn[q][j] = ((const f32x4*)(X + (size_t)(nrow + q * NGW) * DM) + lane)[64 * j]; }
#pragma unroll
                for (int q = 0; q < 2; ++q) { u32x2* o8 = (u32x2*)(XB + (size_t)(row + q * NGW) * DM) + lane;
#pragma unroll
                    for (int j = 0; j < 4; ++j) { u32x2 w; w.x = cvtpk(v[q][j][0], v[q][j][1]); w.y = cvtpk(v[q][j][2], v[q][j][3]); o8[64 * j] = w; } }
#pragma unroll 1
                for (int cg = 0; cg < 4; ++cg) {
                    float sacc[8];
#pragma unroll
                    for (int ci = 0; ci < 4; ++ci) { f32x2 s2 = (f32x2){0.f, 0.f};
#pragma unroll
                        for (int j = 0; j < 4; ++j) { const f32x4 w = *(const LAS f32x4*)(wdt + (4 * cg + ci) * 1024 + 256 * j + 4 * lane);
#pragma unroll
                            for (int e = 0; e < 4; ++e) s2 = __builtin_elementwise_fma((f32x2){v[0][j][e], v[1][j][e]}, (f32x2){w[e], w[e]}, s2); }
                        sacc[ci] = s2[0]; sacc[4 + ci] = s2[1]; }
                    bfly_reduce<8>(sacc, lane);
                    if ((lane & 7) == 0) DT[(size_t)(row + (lane >> 5) * NGW) * 16 + 4 * cg + ((lane >> 3) & 3)] = sacc[0];
                }
#pragma unroll
                for (int q = 0; q < 2; ++q)
#pragma unroll
                    for (int j = 0; j < 4; ++j) v[q][j] = vn[q][j];
            }
        }
    }
    SEAM(0);

    REP(1) if (IN(1)) {
        int tid = threadIdx.x; asm volatile("" : "+v"(tid)); tid &= 511; const int lane = tid & 63; (void)lane;
        pg8::StaticOrder S; S.init(NTOK, PROJW, G, bx, WIN); pg8::IdentityRows RM; pg8::EpiProj E{PROJ, rope};
        pg8::gemm_phase(lds, XB, S, RM, E);
    }
    steal_wait();

    REP(2) if (IN(2)) {
        int tid = threadIdx.x; asm volatile("" : "+v"(tid)); tid &= 511; const int lane = tid & 63; (void)lane;
        REP(14) {
            const float* cwp = INP(CONV_W); const float* cbp = INP(CONV_B);
            for (int item = gw; item < (NTOK / 16) * 2; item += NGW) {
                const int half = item & 1, run = item >> 1, c8 = half * 512 + lane * 8, tok0 = run * 16, pos0 = tok0 & (SEQ - 1);
                f32x4 wv[5][2], bv[2];
#pragma unroll
                for (int j = 0; j < 5; ++j) { wv[j][0] = *(const f32x4*)(cwp + j * 1024 + c8); wv[j][1] = *(const f32x4*)(cwp + j * 1024 + c8 + 4); }
                bv[0] = *(const f32x4*)(cbp + c8); bv[1] = *(const f32x4*)(cbp + c8 + 4);
                u32x4 rows[20];
#pragma unroll
                for (int t = 0; t < 20; ++t) { const int p = pos0 + t - 2;
                    rows[t] = (p >= 0 && p < SEQ) ? *(const u32x4*)(PROJ + (size_t)(tok0 + t - 2) * PROJW + COL_X + c8) : (u32x4){0u, 0u, 0u, 0u}; }
#pragma unroll
                for (int t = 0; t < 16; ++t) { f32x4 a0 = bv[0], a1 = bv[1];
#pragma unroll
                    for (int j = 0; j < 5; ++j) { const u32x4 w = rows[t + j];
                        a0 += (f32x4){bflo(w.x), bfhi(w.x), bflo(w.y), bfhi(w.y)} * wv[j][0]; a1 += (f32x4){bflo(w.z), bfhi(w.z), bflo(w.w), bfhi(w.w)} * wv[j][1]; }
#pragma unroll
                    for (int e = 0; e < 4; ++e) { a0[e] = a0[e] * __builtin_amdgcn_rcpf(1.0f + __expf(-a0[e])); a1[e] = a1[e] * __builtin_amdgcn_rcpf(1.0f + __expf(-a1[e])); }
                    u32x4 o; o.x = cvtpk(a0[0], a0[1]); o.y = cvtpk(a0[2], a0[3]); o.z = cvtpk(a1[0], a1[1]); o.w = cvtpk(a1[2], a1[3]);
                    *(u32x4*)(XBC2 + (size_t)(tok0 + t) * 1024 + c8) = o; __builtin_amdgcn_sched_barrier(0); }
            }
        }
        REP(13) attn_pass<1, true>(PROJ, ATTO, ML, lds, vcu, G, wave, lane);
    }
    steal_wait();

    if (IN(3)) {
        int tid = threadIdx.x; asm volatile("" : "+v"(tid)); tid &= 511; const int lane = tid & 63; (void)lane;
        REP(3) ssd_pass_a(XBC2, DT, ST, CD, INP(A_LOG_F), INP(A_LOG_B), INP(DT_BIAS_F), INP(DT_BIAS_B), lds, vcu, G, tid, wave, lane);
        attn_pass<4, false>(PROJ, ATTO, ML, lds, vcu, G, wave, lane);
    }
    steal_wait();

    if (IN(4)) {
        int tid = threadIdx.x; asm volatile("" : "+v"(tid)); tid &= 511; const int lane = tid & 63; (void)lane; ssd_pass_b(ST, CD, gw * 64 + lane, NGW * 64); attn_pass<16, false>(PROJ, ATTO, ML, lds, vcu, G, wave, lane); }
    steal_wait();

    REP(5) if (IN(5)) { int tid = threadIdx.x; asm volatile("" : "+v"(tid)); tid &= 511; const int lane = tid & 63;
        ssd_pass_c(XBC2, DT, ST, PROJ, MIX8, INP(A_LOG_F), INP(A_LOG_B), INP(DT_BIAS_F), INP(DT_BIAS_B), INP(D_SKIP), INP(SSD_NORM_W), lds, vcu, G, tid, wave, lane);
        const float* nwp = INP(ATTN_NORM_W) + 8 * lane; const f32x4 nw0 = *(const f32x4*)nwp, nw1 = *(const f32x4*)(nwp + 4);
        for (int tok0 = gw; tok0 < NTOK; tok0 += 4 * NGW) {
            u32x4 wv[4];
#pragma unroll
            for (int q = 0; q < 4; ++q) { const int tok = tok0 + q * NGW; wv[q] = tok < NTOK ? *(const u32x4*)(ATTO + (size_t)tok * 512 + 8 * lane) : (u32x4){0u, 0u, 0u, 0u}; }
#pragma unroll
            for (int q = 0; q < 4; ++q) { const int tok = tok0 + q * NGW; const u32x4 w = wv[q];
                float v[8] = {bflo(w.x), bfhi(w.x), bflo(w.y), bfhi(w.y), bflo(w.z), bfhi(w.z), bflo(w.w), bfhi(w.w)};
                float ss = 0.f;
#pragma unroll
                for (int e = 0; e < 8; ++e) ss += v[e] * v[e];
                ss = wave_sum(ss); const float r = 1.0f / sqrtf(ss * (1.0f / 512.0f) + EPS);
                const float r16 = r * F8_SCALE_M;
                int lo = __builtin_amdgcn_cvt_pk_fp8_f32(v[0] * r16 * nw0[0], v[1] * r16 * nw0[1], 0, false); lo = __builtin_amdgcn_cvt_pk_fp8_f32(v[2] * r16 * nw0[2], v[3] * r16 * nw0[3], lo, true);
                int hi = __builtin_amdgcn_cvt_pk_fp8_f32(v[4] * r16 * nw1[0], v[5] * r16 * nw1[1], 0, false); hi = __builtin_amdgcn_cvt_pk_fp8_f32(v[6] * r16 * nw1[2], v[7] * r16 * nw1[3], hi, true);
                if (tok < NTOK) *(u32x2*)(MIX8 + (size_t)tok * 1024 + 8 * lane) = (u32x2){(unsigned)lo, (unsigned)hi}; }
        }
    }
    steal_wait();

    REP(7) if (IN(7)) {
        int tid = threadIdx.x; asm volatile("" : "+v"(tid)); tid &= 511; const int lane = tid & 63; (void)lane;
        pg8::StaticOrder S; S.init(NTOK, DM, G, bx, WOUT8, pg8::KD); pg8::IdentityRows RM; pg8::EpiOut E{XB, PRE1, 1.0f / (F8_SCALE_M * F8_SCALE_D)};
        pg8::gemm_phase<true>(lds, MIX8, S, RM, E);
    }
    steal_wait();

    REP(8) if (IN(8)) {
        int tid = threadIdx.x; asm volatile("" : "+v"(tid)); tid &= 511; const int lane = tid & 63; (void)lane;
        LAS float* rwT = (LAS float*)lds;
        { const float* rw = INP(ROUTER_W);
#pragma unroll 1
          for (int b0 = 0; b0 < 64; b0 += 16) { float t[16];
#pragma unroll
              for (int u = 0; u < 16; ++u) t[u] = rw[tid + (b0 + u) * NTHREADS];
#pragma unroll
              for (int u = 0; u < 16; ++u) { const int i = tid + (b0 + u) * NTHREADS; rwT[(i & 31) * 1028 + (i >> 5)] = t[u]; } } }
        LAS int* hist = (LAS int*)(lds + LM_HIST); LAS int* base = (LAS int*)(lds + LM_BASE); LAS int* pick = (LAS int*)(lds + LM_PICK);
        LAS float* lgs = (LAS float*)(lds + 131584) + wave * 128;
        f32x4 lw[4], lb[4];
#pragma unroll
        for (int j = 0; j < 4; ++j) { lw[j] = ((const f32x4*)INP(LN1_W))[64 * j + lane]; lb[j] = ((const f32x4*)INP(LN1_B))[64 * j + lane]; }
        const float rbias0 = INP(ROUTER_B)[lane & 15], rbias1 = INP(ROUTER_B)[16 + (lane & 15)];
        for (int vb = bx; vb < 256; vb += G) {
            if (tid < 32) hist[tid] = 0;
            __syncthreads();
            const int tokw = vb * 128 + wave * 16;
            f32x4 v[4][4]; u32x2 vn[4][4];
#pragma unroll
            for (int q = 0; q < 4; ++q)
#pragma unroll
                for (int j = 0; j < 4; ++j) { const u32x2 w = ((const u32x2*)(PRE1 + (size_t)(tokw + q) * DM) + lane)[64 * j]; v[q][j] = (f32x4){bflo(w.x), bfhi(w.x), bflo(w.y), bfhi(w.y)}; }
#pragma unroll 1
            for (int qi = 0; qi < 4; ++qi) {
                const int tok0 = tokw + 4 * qi;
                if (qi < 3) {
#pragma unroll
                    for (int q = 0; q < 4; ++q)
#pragma unroll
                        for (int j = 0; j < 4; ++j) vn[q][j] = ((const u32x2*)(PRE1 + (size_t)(tok0 + 4 + q) * DM) + lane)[64 * j]; }
#pragma unroll
                for (int q = 0; q < 4; ++q) { float s = 0.f;
#pragma unroll
                    for (int j = 0; j < 4; ++j) s += (v[q][j][0] + v[q][j][1]) + (v[q][j][2] + v[q][j][3]);
                    const float mean = wave_sum(s) * (1.0f / DM); float s2 = 0.f;
#pragma unroll
                    for (int j = 0; j < 4; ++j) { v[q][j] = v[q][j] - mean; s2 += (v[q][j][0] * v[q][j][0] + v[q][j][1] * v[q][j][1]) + (v[q][j][2] * v[q][j][2] + v[q][j][3] * v[q][j][3]); }
                    const float rstd = 1.0f / sqrtf(wave_sum(s2) * (1.0f / DM) + EPS);
                    u32x2* o8 = (u32x2*)(H1 + (size_t)(tok0 + q) * DM) + lane;
#pragma unroll
                    for (int j = 0; j < 4; ++j) { v[q][j] = v[q][j] * rstd * lw[j] + lb[j]; u32x2 w; w.x = cvtpk(v[q][j][0], v[q][j][1]); w.y = cvtpk(v[q][j][2], v[q][j][3]); o8[64 * j] = w;
                        int p8 = __builtin_amdgcn_cvt_pk_fp8_f32(v[q][j][0] * F8_SCALE_H, v[q][j][1] * F8_SCALE_H, 0, false); p8 = __builtin_amdgcn_cvt_pk_fp8_f32(v[q][j][2] * F8_SCALE_H, v[q][j][3] * F8_SCALE_H, p8, true);
                        ((int*)(H1F8 + (size_t)(tok0 + q) * DM))[64 * j + lane] = p8; } }
                f32x2 hp[2][4][4];
#pragma unroll
                for (int j = 0; j < 4; ++j)
#pragma unroll
                    for (int e = 0; e < 4; ++e) { hp[0][j][e] = (f32x2){v[0][j][e], v[1][j][e]}; hp[1][j][e] = (f32x2){v[2][j][e], v[3][j][e]}; }
#pragma unroll 1
                for (int eg = 0; eg < 8; ++eg) {
                    float sacc[16];
#pragma unroll
                    for (int ei = 0; ei < 4; ++ei) { f32x2 sa = (f32x2){0.f, 0.f}, sb = (f32x2){0.f, 0.f};
#pragma unroll
                        for (int j = 0; j < 4; ++j) { const f32x4 w = *(const LAS f32x4*)(rwT + (4 * eg + ei) * 1028 + 256 * j + 4 * lane);
#pragma unroll
                            for (int e = 0; e < 4; ++e) { const f32x2 ww = (f32x2){w[e], w[e]}; sa = __builtin_elementwise_fma(hp[0][j][e], ww, sa); sb = __builtin_elementwise_fma(hp[1][j][e], ww, sb); } }
                        sacc[ei] = sa[0]; sacc[4 + ei] = sa[1]; sacc[8 + ei] = sb[0]; sacc[12 + ei] = sb[1]; }
                    bfly_reduce<16>(sacc, lane);
                    if ((lane & 3) == 0) lgs[(lane >> 4) * 32 + 4 * eg + ((lane >> 2) & 3)] = sacc[0];
                }
                const int e0 = lane & 15;
                float l0 = lgs[(lane >> 4) * 32 + e0] + rbias0, l1 = lgs[(lane >> 4) * 32 + 16 + e0] + rbias1;
                int sel[4]; float sv[4];
#pragma unroll
                for (int r = 0; r < 4; ++r) { float bv = l0; int bi = e0; if (l1 > l0) { bv = l1; bi = 16 + e0; }
#define TOPK_STEP(M) { const float ov = lane_xor_f<M>(bv, lane); const int oi = lane_xor_i<M>(bi, lane); if (ov > bv || (ov == bv && oi < bi)) { bv = ov; bi = oi; } }
                    TOPK_STEP(1) TOPK_STEP(2) TOPK_STEP(4) TOPK_STEP(8)
#undef TOPK_STEP
                    sel[r] = bi; sv[r] = bv; if (bi == e0) l0 = -INFINITY; if (bi == 16 + e0) l1 = -INFINITY; }
                const float e1 = __expf(sv[1] - sv[0]), e2 = __expf(sv[2] - sv[0]), e3 = __expf(sv[3] - sv[0]); const float inv = 1.0f / (1.0f + e1 + e2 + e3);
                if ((lane & 15) == 0) { const int tok = tok0 + (lane >> 4);
                    *(f32x4*)(TOPG + (size_t)tok * 4) = (f32x4){inv, e1 * inv, e2 * inv, e3 * inv};
#pragma unroll
                    for (int r = 0; r < 4; ++r) { const int rank = __hip_atomic_fetch_add(hist + sel[r], 1, __ATOMIC_RELAXED, __HIP_MEMORY_SCOPE_WORKGROUP); pick[(tok - vb * 128) * 4 + r] = sel[r] | (rank << 8); } }
#pragma unroll
                for (int q = 0; q < 4; ++q)
#pragma unroll
                    for (int j = 0; j < 4; ++j) { const u32x2 w = vn[q][j]; v[q][j] = (f32x4){bflo(w.x), bfhi(w.x), bflo(w.y), bfhi(w.y)}; }
            }
            __syncthreads();
            if (tid < 32) base[tid] = __hip_atomic_fetch_add(GCNT + tid, hist[tid], __ATOMIC_RELAXED, __HIP_MEMORY_SCOPE_AGENT);
            __syncthreads();
            { const int p = pick[tid], e = p & 255, slot = base[e] + (p >> 8), tok = vb * 128 + (tid >> 2);
              TOKV[e * NTOK + slot] = tok; ROWOF[tok * 4 + (tid & 3)] = (e << 20) | slot; }
            __syncthreads();
        }
    }
    steal_drain();


    REP(10) if (IN(10)) {
        int tid = threadIdx.x; asm volatile("" : "+v"(tid)); tid &= 511; const int lane = tid & 63; (void)lane;
        LAS int* segt = (LAS int*)(lds + LM_SEGT); LAS int* segc = (LAS int*)(lds + LM_SEGC);
        if (tid < 64) { const int c = tid < 32 ? __hip_atomic_load(GCNT + (tid & 31), __ATOMIC_RELAXED, __HIP_MEMORY_SCOPE_AGENT) : 0; int t = (c + 255) >> 8;
#pragma unroll
            for (int d = 1; d < 32; d <<= 1) { const int o = __shfl_up(t, d, 64); if ((tid & 63) >= d) t += o; }
            if (tid < 32) { segc[tid] = c; segt[tid + 1] = t; } if (tid == 0) segt[0] = 0; }
        __syncthreads();
        pg8::GroupedOrder S{0, segt[32], 8, G, vcu, 0, segt, segc, (const char*)WGU8, (size_t)2048 * 1024, 1024, 0};
        pg8::TableRows RM{TOKV}; pg8::EpiAct E{ACT8, INP(B_GATE), INP(B_UP), 1.0f / (F8_SCALE_H * F8_SCALE_W)};
        pg8::gemm_phase<true>(lds, H1F8, S, RM, E);
    }
    SEAM(10);

    REP(11) if (IN(11)) {
        int tid = threadIdx.x; asm volatile("" : "+v"(tid)); tid &= 511; const int lane = tid & 63; (void)lane;
        LAS int* segt = (LAS int*)(lds + LM_SEGT); LAS int* segc = (LAS int*)(lds + LM_SEGC);
        if (tid < 64) { const int c = tid < 32 ? __hip_atomic_load(GCNT + (tid & 31), __ATOMIC_RELAXED, __HIP_MEMORY_SCOPE_AGENT) : 0; int t = (c + 255) >> 8;
#pragma unroll
            for (int d = 1; d < 32; d <<= 1) { const int o = __shfl_up(t, d, 64); if ((tid & 63) >= d) t += o; }
            if (tid < 32) { segc[tid] = c; segt[tid + 1] = t; } if (tid == 0) segt[0] = 0; }
        __syncthreads();
        pg8::GroupedOrder S{0, segt[32], 4, G, vcu, 0, segt, segc, (const char*)WDN8, (size_t)1024 * 1024, 1024, 0};
        pg8::IdentityRows RM; pg8::EpiY E{Y8, INP(B_DOWN), 1.0f / (F8_SCALE_A * F8_SCALE_D)};
        pg8::gemm_phase<true>(lds, ACT8, S, RM, E);
    }
    SEAM(11);

    REP(12) if (IN(12)) {
        int tid = threadIdx.x; asm volatile("" : "+v"(tid)); tid &= 511; const int lane = tid & 63; (void)lane;
        LAS int* segt = (LAS int*)(lds + LM_SEGT); LAS int* segc = (LAS int*)(lds + LM_SEGC);
        if (tid < 64) { const int c = tid < 32 ? __hip_atomic_load(GCNT + (tid & 31), __ATOMIC_RELAXED, __HIP_MEMORY_SCOPE_AGENT) : 0; int t = (c + 255) >> 8;
#pragma unroll
            for (int d = 1; d < 32; d <<= 1) { const int o = __shfl_up(t, d, 64); if ((tid & 63) >= d) t += o; }
            if (tid < 32) { segc[tid] = c; segt[tid + 1] = t; } if (tid == 0) segt[0] = 0; }
        __syncthreads();
        f32x4 lw[4], lb[4];
#pragma unroll
        for (int j = 0; j < 4; ++j) { lw[j] = ((const f32x4*)INP(LN2_W))[64 * j + lane]; lb[j] = ((const f32x4*)INP(LN2_B))[64 * j + lane]; }
#define YROW(w) (segt[(w) >> 20] * 256 + ((w) & 0xFFFFF))
        int tok = gw; int4 rws = make_int4(0, 0, 0, 0); f32x4 gts = (f32x4){0.f, 0.f, 0.f, 0.f};
        if (tok < NTOK) { rws = *(const int4*)(ROWOF + (size_t)tok * 4); gts = *(const f32x4*)(TOPG + (size_t)tok * 4); }
        u32x2 hw[4]; unsigned yw[4][4];
        if (tok < NTOK) { const u32x2* hp = (const u32x2*)(H1 + (size_t)tok * DM) + lane; const int rwa[4] = {YROW(rws.x), YROW(rws.y), YROW(rws.z), YROW(rws.w)};
#pragma unroll
            for (int j = 0; j < 4; ++j) hw[j] = hp[64 * j];
#pragma unroll
            for (int k = 0; k < 4; ++k) { const unsigned* yp = (const unsigned*)(Y8 + (size_t)rwa[k] * 1024) + lane;
#pragma unroll
                for (int j = 0; j < 4; ++j) yw[k][j] = yp[64 * j]; } }
        for (; tok < NTOK; tok += NGW) {
            const int ntok = tok + NGW; int4 nrws = rws; f32x4 ngts = gts;
            if (ntok < NTOK) { nrws = *(const int4*)(ROWOF + (size_t)ntok * 4); ngts = *(const f32x4*)(TOPG + (size_t)ntok * 4); }
            f32x4 v[4];
#pragma unroll
            for (int j = 0; j < 4; ++j) v[j] = (f32x4){bflo(hw[j].x), bfhi(hw[j].x), bflo(hw[j].y), bfhi(hw[j].y)} * ALPHA;
#pragma unroll
            for (int k = 0; k < 4; ++k) { const float gk = gts[k] * (1.0f / F8_SCALE_Y);
#pragma unroll
                for (int j = 0; j < 4; ++j) { const unsigned w = yw[k][j]; const f32x2 lo2 = __builtin_amdgcn_cvt_pk_f32_fp8(w, false), hi2 = __builtin_amdgcn_cvt_pk_f32_fp8(w, true);
                    v[j] = v[j] + (f32x4){lo2[0], lo2[1], hi2[0], hi2[1]} * gk; } }
            if (ntok < NTOK) { const u32x2* hp = (const u32x2*)(H1 + (size_t)ntok * DM) + lane; const int rwa[4] = {YROW(nrws.x), YROW(nrws.y), YROW(nrws.z), YROW(nrws.w)};
#pragma unroll
                for (int j = 0; j < 4; ++j) hw[j] = hp[64 * j];
#pragma unroll
                for (int k = 0; k < 4; ++k) { const unsigned* yp = (const unsigned*)(Y8 + (size_t)rwa[k] * 1024) + lane;
#pragma unroll
                    for (int j = 0; j < 4; ++j) yw[k][j] = yp[64 * j]; } }
            float sm = 0.f;
#pragma unroll
            for (int j = 0; j < 4; ++j) sm += (v[j][0] + v[j][1]) + (v[j][2] + v[j][3]);
            const float mean = wave_sum(sm) * (1.0f / DM); float s2 = 0.f;
#pragma unroll
            for (int j = 0; j < 4; ++j) { v[j] = v[j] - mean; s2 += (v[j][0] * v[j][0] + v[j][1] * v[j][1]) + (v[j][2] * v[j][2] + v[j][3] * v[j][3]); }
            const float rstd = 1.0f / sqrtf(wave_sum(s2) * (1.0f / DM) + EPS);
            f32x4* op = (f32x4*)(a.out + (size_t)tok * DM) + lane;
#pragma unroll
            for (int j = 0; j < 4; ++j) op[64 * j] = v[j] * rstd * lw[j] + lb[j];
            rws = nrws; gts = ngts;
        }
    }
#undef IN
#undef SEAM
}

constexpr int N_PHASES = 13;
extern "C" void kernel_launch(void* const* d_in, const int* in_sizes, int n_in, void* d_out, int out_size, void* d_ws, size_t ws_size, hipStream_t stream) {
    static int grid = 0;
    if (grid == 0) {
        if (n_in != 24 || out_size != NTOK * DM || ws_size < WS_END) { fprintf(stderr, "kernel_launch: unexpected shapes (n_in %d out %d ws %zu)\n", n_in, out_size, ws_size); grid = -1; return; }
        int dev = 0, cus = 0, per_cu = 0;
        if (hipGetDevice(&dev) != hipSuccess || hipDeviceGetAttribute(&cus, hipDeviceAttributeMultiprocessorCount, dev) != hipSuccess) { grid = -1; return; }
        if (hipFuncSetAttribute((const void*)hymba_fwd, hipFuncAttributeMaxDynamicSharedMemorySize, LDS_BYTES) != hipSuccess) { fprintf(stderr, "kernel_launch: hipFuncSetAttribute failed\n"); grid = -1; return; }
        if (hipOccupancyMaxActiveBlocksPerMultiprocessor(&per_cu, (const void*)hymba_fwd, NTHREADS, LDS_BYTES) != hipSuccess || per_cu < 1) { fprintf(stderr, "kernel_launch: occupancy query says %d\n", per_cu); }
        (void)hipGetLastError();
        grid = cus;
    }
    if (grid < 0) return;
    (void)hipMemsetAsync((char*)d_ws + WS_CTL, 0, CTL_ZERO_BYTES, stream);
    Args a{};
    for (int i = 0; i < 24; ++i) a.in[i] = (const float*)d_in[i];
    a.out = (float*)d_out; a.ws = (unsigned char*)d_ws; a.ph_lo = 0; a.ph_hi = N_PHASES;
    hipLaunchKernelGGL(hymba_fwd, dim3(grid), dim3(NTHREADS), LDS_BYTES, stream, a);
}
```
